# Optimizing an MI355X kernel written in HIP

```python
import math
import jax, jax.numpy as jnp
from jax import lax
import numpy as np

D_MODEL = 1024
BATCH = 8
SEQ = 4096
DEPTH = 1

MIX_WIDTH = D_MODEL
GLA_HEADS = 4
GLA_DV = MIX_WIDTH // 2 // GLA_HEADS
GLA_DK = GLA_DV // 2
GLA_GATE_RANK = 16
GLA_GATE_NORM = 16.0
GLA_CHUNK = 64
SWA_HEAD_DIM = 64
SWA_Q_HEADS = MIX_WIDTH // 2 // SWA_HEAD_DIM
SWA_KV_HEADS = 2
SWA_BLOCK = 128
SWA_WINDOW = 128
REL_BUCKETS = 32
REL_MAX_DIST = 128
D_FF = 4 * D_MODEL
NORM_EPS = 1e-6

COL_SIZES = (
    GLA_HEADS * GLA_DK,
    GLA_HEADS * GLA_DK,
    GLA_HEADS * GLA_DV,
    GLA_HEADS * GLA_DV,
    2 * GLA_GATE_RANK,
    SWA_Q_HEADS * SWA_HEAD_DIM,
    SWA_KV_HEADS * SWA_HEAD_DIM,
    SWA_KV_HEADS * SWA_HEAD_DIM,
)
IN_COLS = int(sum(COL_SIZES))
SPLITS = [int(s) for s in np.cumsum(COL_SIZES)[:-1]]

kernel_name = "hybrid_gla_swa_bidir_encoder_layer"


def rmsnorm(x, g):
    xf = x.astype(jnp.float32)
    r = lax.rsqrt(jnp.mean(xf * xf, axis=-1, keepdims=True) + NORM_EPS)
    return (xf * r).astype(x.dtype) * g


def t5_buckets(rel):
    nb = REL_BUCKETS // 2
    ret = (rel > 0).astype(np.int32) * nb
    n = np.abs(rel)
    max_exact = nb // 2
    large = max_exact + (np.log(np.maximum(n, 1).astype(np.float32) / max_exact)
                         / math.log(REL_MAX_DIST / max_exact) * (nb - max_exact)).astype(np.int32)
    large = np.minimum(large, nb - 1)
    return ret + np.where(n < max_exact, n, large)


def gla_chunked(q, k, v, log_a):
    B, H, L, dk = q.shape
    dv = v.shape[-1]
    C = GLA_CHUNK
    N = L // C
    q = q.reshape(B, H, N, C, dk)
    k = k.reshape(B, H, N, C, dk)
    v = v.reshape(B, H, N, C, dv)
    b = jnp.cumsum(log_a.reshape(B, H, N, C, dk), axis=3)
    b_last = b[:, :, :, -1:, :]
    q_dec = q * jnp.exp(b)
    k_intra = k * jnp.exp(-b)
    k_state = k * jnp.exp(b_last - b)
    causal = jnp.asarray(np.tril(np.ones((C, C), dtype=bool)))
    A = jnp.where(causal, jnp.einsum('bhncd,bhnsd->bhncs', q_dec, k_intra), 0.0)
    o_intra = jnp.einsum('bhncs,bhnse->bhnce', A, v)
    dS = jnp.einsum('bhncd,bhnce->bhnde', k_state, v)
    decay = jnp.exp(b_last[:, :, :, 0, :])

    def step(S, inp):
        d, ds = inp
        return d[..., None] * S + ds, S

    S0 = jnp.zeros((B, H, dk, dv), jnp.float32)
    _, S_enter = lax.scan(step, S0, (jnp.moveaxis(decay, 2, 0), jnp.moveaxis(dS, 2, 0)))
    S_enter = jnp.moveaxis(S_enter, 0, 2)
    o_inter = jnp.einsum('bhncd,bhnde->bhnce', q_dec, S_enter)
    return (o_intra + o_inter).reshape(B, H, L, dv)


def banded_window_gqa(q, k, v, sink, rel_table):
    B, Hq, L, dh = q.shape
    Hkv = k.shape[1]
    G = Hq // Hkv
    W = SWA_BLOCK
    N = L // W
    qb = q.reshape(B, Hkv, G, N, W, dh)

    def band(t):
        tp = jnp.pad(t, ((0, 0), (0, 0), (W, W), (0, 0))).reshape(B, Hkv, N + 2, W, dh)
        return jnp.concatenate([tp[:, :, :N], tp[:, :, 1:N + 1], tp[:, :, 2:N + 2]], axis=3)

    kb, vb = band(k), band(v)
    c = np.arange(W)[:, None]
    s = np.arange(3 * W)[None, :]
    rel = s - W - c
    key_pos = (np.arange(N)[:, None, None] - 1) * W + s[None]
    mask = jnp.asarray((np.abs(rel)[None] <= SWA_WINDOW) & (key_pos >= 0) & (key_pos < L))
    bias = rel_table.astype(jnp.float32)[jnp.asarray(t5_buckets(rel))]
    bias = jnp.transpose(bias, (2, 0, 1)).reshape(Hkv, G, 1, W, 3 * W)

    logits = jnp.einsum('bkgncd,bknsd->bkgncs', qb, kb).astype(jnp.float32) * (dh ** -0.5) + bias
    logits = jnp.where(mask, logits, -1e30)
    sink_l = sink.astype(jnp.float32).reshape(Hkv, G, 1, 1, 1)
    m = jnp.maximum(jnp.max(logits, axis=-1, keepdims=True), sink_l)
    p = jnp.exp(logits - m)
    denom = jnp.sum(p, axis=-1, keepdims=True) + jnp.exp(sink_l - m)
    o = jnp.einsum('bkgncs,bknsd->bkgncd', (p / denom).astype(v.dtype), vb)
    return o.reshape(B, Hq, L, dh)


def hybrid_mixer(u, w_in, w_gu_f, b_g_f, w_gu_b, b_g_b, gla_norm, sink, rel_table, w_out):
    B, L, _ = u.shape
    proj = u @ w_in
    qa, ka, va, ga, za, qs, ks, vs = jnp.split(proj, SPLITS, axis=-1)

    def heads(t, h):
        return t.reshape(B, L, h, -1).transpose(0, 2, 1, 3)

    f32 = jnp.float32
    qh = heads(qa, GLA_HEADS).astype(f32) * (GLA_DK ** -0.5)
    kh = heads(ka, GLA_HEADS).astype(f32)
    vh = heads(va, GLA_HEADS).astype(f32)
    zf, zb = za[..., :GLA_GATE_RANK], za[..., GLA_GATE_RANK:]
    la_f = heads(jax.nn.log_sigmoid((zf @ w_gu_f + b_g_f).astype(f32)) / GLA_GATE_NORM, GLA_HEADS)
    la_b = heads(jax.nn.log_sigmoid((zb @ w_gu_b + b_g_b).astype(f32)) / GLA_GATE_NORM, GLA_HEADS)
    o_f = gla_chunked(qh, kh, vh, la_f)
    flip = lambda t: jnp.flip(t, axis=2)
    o_b = flip(gla_chunked(flip(qh), flip(kh), flip(vh), flip(la_b)))
    o_a = o_f + o_b
    o_a = o_a * lax.rsqrt(jnp.mean(o_a * o_a, axis=-1, keepdims=True) + NORM_EPS)
    o_a = o_a.transpose(0, 2, 1, 3) * gla_norm.astype(f32)
    o_a = (o_a.reshape(B, L, GLA_HEADS * GLA_DV) * jax.nn.silu(ga.astype(f32))).astype(u.dtype)

    o_s = banded_window_gqa(heads(qs, SWA_Q_HEADS), heads(ks, SWA_KV_HEADS), heads(vs, SWA_KV_HEADS),
                            sink, rel_table)
    o_s = o_s.transpose(0, 2, 1, 3).reshape(B, L, SWA_Q_HEADS * SWA_HEAD_DIM)

    return jnp.concatenate([o_a, o_s], axis=-1) @ w_out


def setup_inputs(seed: int = 0) -> dict:
    key = jax.random.key(seed)
    ks = jax.random.split(key, 20)
    nrm = lambda k, shape, scale: jax.random.normal(k, shape, jnp.float32) * scale
    gain = lambda k, shape: 1.0 + nrm(k, shape, 0.02)
    gla_w = GLA_HEADS * GLA_DK
    return {
        "x": nrm(ks[0], (BATCH, SEQ, D_MODEL), 1.0),
        "norm_mix_pre": gain(ks[1], (DEPTH, D_MODEL)),
        "w_in": nrm(ks[2], (DEPTH, D_MODEL, IN_COLS), D_MODEL ** -0.5),
        "w_gate_up_fwd": nrm(ks[3], (DEPTH, GLA_GATE_RANK, gla_w), GLA_GATE_RANK ** -0.5),
        "b_gate_fwd": nrm(ks[4], (DEPTH, gla_w), 0.1),
        "w_gate_up_bwd": nrm(ks[5], (DEPTH, GLA_GATE_RANK, gla_w), GLA_GATE_RANK ** -0.5),
        "b_gate_bwd": nrm(ks[6], (DEPTH, gla_w), 0.1),
        "gla_norm": gain(ks[7], (DEPTH, GLA_DV)),
        "swa_sink": nrm(ks[8], (DEPTH, SWA_Q_HEADS), 0.5),
        "rel_bias": nrm(ks[9], (REL_BUCKETS, SWA_Q_HEADS), 0.5),
        "w_out": nrm(ks[10], (DEPTH, MIX_WIDTH, D_MODEL), MIX_WIDTH ** -0.5),
        "norm_mix_post": gain(ks[11], (DEPTH, D_MODEL)),
        "norm_mlp_pre": gain(ks[12], (DEPTH, D_MODEL)),
        "w_up": nrm(ks[13], (DEPTH, D_MODEL, D_FF), D_MODEL ** -0.5),
        "w_down": nrm(ks[14], (DEPTH, D_FF, D_MODEL), D_FF ** -0.5),
        "norm_mlp_post": gain(ks[15], (DEPTH, D_MODEL)),
    }


def reference(x, norm_mix_pre, w_in, w_gate_up_fwd, b_gate_fwd, w_gate_up_bwd, b_gate_bwd,
              gla_norm, swa_sink, rel_bias, w_out, norm_mix_post, norm_mlp_pre, w_up, w_down,
              norm_mlp_post):
    h = x
    for l in range(DEPTH):
        u = rmsnorm(h, norm_mix_pre[l])
        mix = hybrid_mixer(u, w_in[l], w_gate_up_fwd[l], b_gate_fwd[l], w_gate_up_bwd[l], b_gate_bwd[l],
                           gla_norm[l], swa_sink[l], rel_bias, w_out[l])
        h = h + rmsnorm(mix, norm_mix_post[l])
        z = rmsnorm(h, norm_mlp_pre[l]) @ w_up[l]
        ff = jnp.square(jax.nn.relu(z)) @ w_down[l]
        h = h + rmsnorm(ff, norm_mlp_post[l])
    return h
```

```cpp
#include <hip/hip_runtime.h>
#include <cstdio>
#include <cstdint>

namespace {
constexpr int D = 1024, BATCH = 8, SEQ = 4096, M = BATCH * SEQ;
constexpr int GH = 4, GDV = 128, GDK = 64, GR = 16;
constexpr int SQH = 8, SKH = 2, SHD = 64, SWIN = 128;
constexpr int FF = 4096, INC = 2336;
constexpr float EPS = 1e-6f;
constexpr int C_GQ = 0, C_GK = 256, C_GV = 512, C_GG = 1024, C_Z = 1536, C_SQ = 1568, C_SK = 2080, C_SV = 2208;

__device__ __forceinline__ float wave_sum(float v) {
#pragma unroll
    for (int o = 1; o < 64; o <<= 1) v += __shfl_xor(v, o);
    return v;
}

__global__ void __launch_bounds__(256) k_rmsnorm(const float* __restrict__ x, const float* __restrict__ g, const float* res, float* out, int rows) {
    const int lane = threadIdx.x & 63, w = (blockIdx.x * 256 + threadIdx.x) >> 6, nw = (gridDim.x * 256) >> 6;
    for (int r = w; r < rows; r += nw) {
        const float4* xr = (const float4*)(x + (size_t)r * D);
        float4 v[4]; float s = 0.f;
#pragma unroll
        for (int j = 0; j < 4; ++j) { v[j] = xr[lane + 64 * j]; s += v[j].x * v[j].x + v[j].y * v[j].y + v[j].z * v[j].z + v[j].w * v[j].w; }
        const float rs = rsqrtf(wave_sum(s) * (1.f / D) + EPS);
#pragma unroll
        for (int j = 0; j < 4; ++j) {
            const float4 gg = ((const float4*)g)[lane + 64 * j];
            float4 o; o.x = v[j].x * rs * gg.x; o.y = v[j].y * rs * gg.y; o.z = v[j].z * rs * gg.z; o.w = v[j].w * rs * gg.w;
            if (res) { const float4 rr = ((const float4*)(res + (size_t)r * D))[lane + 64 * j]; o.x += rr.x; o.y += rr.y; o.z += rr.z; o.w += rr.w; }
            ((float4*)(out + (size_t)r * D))[lane + 64 * j] = o;
        }
    }
}

template <int ACT>
__global__ void __launch_bounds__(256) k_sgemm(const float* __restrict__ A, const float* __restrict__ B, float* __restrict__ C, int Mr, int N, int K) {
    __shared__ float As[16][132];
    __shared__ float Bs[16][68];
    const int tid = threadIdx.x, ty = tid >> 4, tx = tid & 15;
    const int m0 = blockIdx.y * 128, n0 = blockIdx.x * 64;
    float acc[8][4];
#pragma unroll
    for (int i = 0; i < 8; ++i)
#pragma unroll
        for (int j = 0; j < 4; ++j) acc[i][j] = 0.f;
    for (int k0 = 0; k0 < K; k0 += 16) {
#pragma unroll
        for (int i = 0; i < 2; ++i) {
            const int idx = tid * 2 + i, row = idx >> 2, kq = idx & 3;
            const float4 a = *(const float4*)(A + (size_t)(m0 + row) * K + k0 + 4 * kq);
            As[4 * kq + 0][row] = a.x; As[4 * kq + 1][row] = a.y; As[4 * kq + 2][row] = a.z; As[4 * kq + 3][row] = a.w;
        }
        {
            const int kr = tid >> 4, c4 = tid & 15; const int col = n0 + 4 * c4;
            float4 b = make_float4(0.f, 0.f, 0.f, 0.f);
            if (col < N) b = *(const float4*)(B + (size_t)(k0 + kr) * N + col);
            *(float4*)&Bs[kr][4 * c4] = b;
        }
        __syncthreads();
#pragma unroll
        for (int k = 0; k < 16; ++k) {
            const float4 a0 = *(const float4*)&As[k][ty * 8], a1 = *(const float4*)&As[k][ty * 8 + 4];
            const float4 b = *(const float4*)&Bs[k][tx * 4];
            const float av[8] = {a0.x, a0.y, a0.z, a0.w, a1.x, a1.y, a1.z, a1.w};
            const float bv[4] = {b.x, b.y, b.z, b.w};
#pragma unroll
            for (int i = 0; i < 8; ++i)
#pragma unroll
                for (int j = 0; j < 4; ++j) acc[i][j] = fmaf(av[i], bv[j], acc[i][j]);
        }
        __syncthreads();
    }
    const int col = n0 + tx * 4;
    if (col < N) {
#pragma unroll
        for (int i = 0; i < 8; ++i) {
            float4 o = make_float4(acc[i][0], acc[i][1], acc[i][2], acc[i][3]);
            if (ACT == 1) { o.x = fmaxf(o.x, 0.f); o.x *= o.x; o.y = fmaxf(o.y, 0.f); o.y *= o.y; o.z = fmaxf(o.z, 0.f); o.z *= o.z; o.w = fmaxf(o.w, 0.f); o.w *= o.w; }
            *(float4*)(C + (size_t)(m0 + ty * 8 + i) * N + col) = o;
        }
    }
}

__device__ __forceinline__ float log_sigmoid(float x) { return fminf(x, 0.f) - log1pf(expf(-fabsf(x))); }

__global__ void __launch_bounds__(64) k_gla_naive(const float* __restrict__ proj, const float* __restrict__ wgf, const float* __restrict__ bgf,
                                                  const float* __restrict__ wgb, const float* __restrict__ bgb, float* __restrict__ of, float* __restrict__ ob) {
    const int lane = threadIdx.x;
    int id = blockIdx.x; const int es = id & 15; id >>= 4; const int dir = id & 1; id >>= 1; const int h = id & 3; const int b = id >> 2;
    const float* wg = dir ? wgb : wgf; const float* bg = dir ? bgb : bgf; float* o = dir ? ob : of;
    float w[16];
#pragma unroll
    for (int r = 0; r < 16; ++r) w[r] = wg[r * 256 + h * 64 + lane];
    const float bias = bg[h * 64 + lane];
    float S[8];
#pragma unroll
    for (int e = 0; e < 8; ++e) S[e] = 0.f;
    for (int i = 0; i < SEQ; ++i) {
        const int t = dir ? (SEQ - 1 - i) : i;
        const float* pr = proj + (size_t)(b * SEQ + t) * INC;
        float pre = bias;
#pragma unroll
        for (int r = 0; r < 16; ++r) pre = fmaf(pr[C_Z + dir * 16 + r], w[r], pre);
        const float a = expf(log_sigmoid(pre) * (1.f / 16.f));
        const float q = pr[C_GQ + h * 64 + lane] * 0.125f, k = pr[C_GK + h * 64 + lane];
        float part[8];
#pragma unroll
        for (int e = 0; e < 8; ++e) { const float v = pr[C_GV + h * 128 + es * 8 + e]; S[e] = fmaf(a, S[e], k * v); part[e] = q * S[e]; }
#pragma unroll
        for (int e = 0; e < 8; ++e) part[e] = wave_sum(part[e]);
        if (lane < 8) { float v = part[0];
#pragma unroll
            for (int e = 1; e < 8; ++e) v = (lane == e) ? part[e] : v;
            o[(size_t)(b * SEQ + t) * 512 + h * 128 + es * 8 + lane] = v; }
    }
}

__global__ void __launch_bounds__(256) k_gla_post(const float* __restrict__ of, const float* __restrict__ ob, const float* __restrict__ proj, const float* __restrict__ gn, float* __restrict__ mix) {
    const int lane = threadIdx.x & 63, w = (blockIdx.x * 256 + threadIdx.x) >> 6;
    const int tok = w >> 2, h = w & 3;
    if (tok >= M) return;
    const size_t off = (size_t)tok * 512 + h * 128;
    const float v0 = of[off + lane] + ob[off + lane], v1 = of[off + 64 + lane] + ob[off + 64 + lane];
    const float rs = rsqrtf(wave_sum(v0 * v0 + v1 * v1) * (1.f / 128.f) + EPS);
    const float g0 = proj[(size_t)tok * INC + C_GG + h * 128 + lane], g1 = proj[(size_t)tok * INC + C_GG + h * 128 + 64 + lane];
    mix[(size_t)tok * D + h * 128 + lane] = v0 * rs * gn[lane] * (g0 / (1.f + expf(-g0)));
    mix[(size_t)tok * D + h * 128 + 64 + lane] = v1 * rs * gn[64 + lane] * (g1 / (1.f + expf(-g1)));
}

__device__ __forceinline__ int t5_bucket(int rel) {
    const int n = rel < 0 ? -rel : rel;
    const int large = 8 + (n >= 12) + (n >= 16) + (n >= 23) + (n >= 32) + (n >= 46) + (n >= 64) + (n >= 91);
    return (rel > 0 ? 16 : 0) + (n < 8 ? n : large);
}

__global__ void __launch_bounds__(256) k_swa_naive(const float* __restrict__ proj, const float* __restrict__ sink, const float* __restrict__ relb, float* __restrict__ mix) {
    __shared__ float qs[4][64];
    __shared__ float ps[4][5 * 64];
    const int lane = threadIdx.x & 63, wv = threadIdx.x >> 6, w = blockIdx.x * 4 + wv;
    const int tok = w >> 3, qh = w & 7, kvh = qh >> 2, b = tok / SEQ, i = tok % SEQ;
    qs[wv][lane] = proj[(size_t)tok * INC + C_SQ + qh * 64 + lane];
    __syncthreads();
    float lg[5]; float mx = sink[qh];
#pragma unroll
    for (int c = 0; c < 5; ++c) {
        const int jj = c * 64 + lane, j = i - SWIN + jj;
        float l = -1e30f;
        if (jj <= 2 * SWIN && j >= 0 && j < SEQ) {
            const float* kr = proj + (size_t)(b * SEQ + j) * INC + C_SK + kvh * 64;
            float dot = 0.f;
            for (int d = 0; d < 64; ++d) dot = fmaf(qs[wv][d], kr[d], dot);
            l = dot * 0.125f + relb[t5_bucket(j - i) * 8 + qh];
        }
        lg[c] = l; mx = fmaxf(mx, l);
    }
#pragma unroll
    for (int o = 1; o < 64; o <<= 1) mx = fmaxf(mx, __shfl_xor(mx, o));
    float den = 0.f;
#pragma unroll
    for (int c = 0; c < 5; ++c) { const float p = (lg[c] > -1e29f) ? expf(lg[c] - mx) : 0.f; ps[wv][c * 64 + lane] = p; den += p; }
    den = wave_sum(den) + expf(sink[qh] - mx);
    __syncthreads();
    float acc = 0.f;
    for (int jj = 0; jj <= 2 * SWIN; ++jj) {
        const int j = i - SWIN + jj;
        if (j < 0 || j >= SEQ) continue;
        acc = fmaf(ps[wv][jj], proj[(size_t)(b * SEQ + j) * INC + C_SV + kvh * 64 + lane], acc);
    }
    mix[(size_t)tok * D + 512 + qh * 64 + lane] = acc / den;
}
}

extern "C" void kernel_launch(void* const* d_in, const int* in_sizes, int n_in, void* d_out, int out_size, void* d_ws, size_t ws_size, hipStream_t stream) {
    const float* x = (const float*)d_in[0];
    const float* g_pre = (const float*)d_in[1];
    const float* w_in = (const float*)d_in[2];
    const float* wgf = (const float*)d_in[3];
    const float* bgf = (const float*)d_in[4];
    const float* wgb = (const float*)d_in[5];
    const float* bgb = (const float*)d_in[6];
    const float* gla_norm = (const float*)d_in[7];
    const float* sink = (const float*)d_in[8];
    const float* relb = (const float*)d_in[9];
    const float* w_out = (const float*)d_in[10];
    const float* g_post = (const float*)d_in[11];
    const float* g_mlp_pre = (const float*)d_in[12];
    const float* w_up = (const float*)d_in[13];
    const float* w_down = (const float*)d_in[14];
    const float* g_mlp_post = (const float*)d_in[15];
    float* out = (float*)d_out;
    const size_t MiB = 1u << 20;
    if (n_in != 16 || in_sizes[0] != M * D || out_size != M * D || ws_size < 512 * MiB) {
        fprintf(stderr, "kernel_launch: unexpected shapes / workspace (n_in %d, in0 %d, out %d, ws %zu)\n", n_in, in_sizes[0], out_size, ws_size);
        return;
    }
    char* ws = (char*)d_ws;
    float* U = (float*)(ws);
    float* MIX = U;
    float* PROJ = (float*)(ws + 128 * MiB);
    float* OF = (float*)(ws + 420 * MiB);
    float* OB = out;
    float* T1 = (float*)(ws + 128 * MiB);
    float* H1 = out;
    float* Hc = (float*)(ws + 256 * MiB);
    float* T2 = (float*)(ws + 384 * MiB);

    k_rmsnorm<<<2048, 256, 0, stream>>>(x, g_pre, nullptr, U, M);
    k_sgemm<0><<<dim3((INC + 63) / 64, M / 128), 256, 0, stream>>>(U, w_in, PROJ, M, INC, D);
    k_gla_naive<<<BATCH * GH * 2 * 16, 64, 0, stream>>>(PROJ, wgf, bgf, wgb, bgb, OF, OB);
    k_gla_post<<<M * 4 / 4, 256, 0, stream>>>(OF, OB, PROJ, gla_norm, MIX);
    k_swa_naive<<<M * 8 / 4, 256, 0, stream>>>(PROJ, sink, relb, MIX);
    k_sgemm<0><<<dim3(D / 64, M / 128), 256, 0, stream>>>(MIX, w_out, T1, M, D, D);
    k_rmsnorm<<<2048, 256, 0, stream>>>(T1, g_post, x, H1, M);
    k_rmsnorm<<<2048, 256, 0, stream>>>(H1, g_mlp_pre, nullptr, U, M);
    for (int c = 0; c < 4; ++c) {
        const int rows = M / 4;
        k_sgemm<1><<<dim3(FF / 64, rows / 128), 256, 0, stream>>>(U + (size_t)c * rows * D, w_up, Hc, rows, FF, D);
        k_sgemm<0><<<dim3(D / 64, rows / 128), 256, 0, stream>>>(Hc, w_down, T2 + (size_t)c * rows * D, rows, D, FF);
    }
    k_rmsnorm<<<2048, 256, 0, stream>>>(T2, g_mlp_post, H1, out, M);
}
```

```cpp
#include <hip/hip_runtime.h>
#include <cstdio>
#include <cstdint>
namespace pg8 {
#define PG8_LAS __attribute__((address_space(3)))
typedef unsigned short bf16_t;
typedef short bf16x8 __attribute__((ext_vector_type(8)));
typedef float f32x4 __attribute__((ext_vector_type(4)));
typedef unsigned u32x4 __attribute__((ext_vector_type(4)));
constexpr int BM = 256, BK = 64, HALF = 128, HTB = HALF * BK * 2  , STAGE_BYTES = 8 * HTB, NXCD = 8, WGM = 8;

__host__ __device__ __forceinline__ int lds_byte(int r, int c) { const int st = (r >> 4) * 2 + (c >> 5), rr = r & 15, cc = c & 31, ob = rr * 64 + cc * 2; return st * 1024 + (ob ^ (((ob >> 9) & 1) << 5)); }
__host__ __device__ __forceinline__ void stage_rc(int b, int& R, int& C) { const int st = b / 1024, sb = b % 1024, swz = sb ^ (((sb >> 9) & 1) << 5); R = (st >> 1) * 16 + swz / 64; C = (st & 1) * 32 + (swz % 64) / 2; }
__host__ __device__ __forceinline__ int perm32(int rho) { const int n = rho >> 4, i = rho & 15; return 8 * (i >> 2) + 4 * n + (i & 3); }

struct Unit { int pm, pn; };
struct Gemm { const bf16_t* A; const bf16_t* Bt; int M, N, K; };

struct StaticOrder {
    int nM, nN, nwg, G, c;
    __host__ __device__ void init(int M, int N, int G_, int c_) { nM = M / BM; nN = N / BM; nwg = nM * nN; G = G_; c = c_; }
    __host__ __device__ bool next(int i, Unit& u) const {
        const long L = (long)i * G + c; if (L >= nwg) return false;
        int wgid = (int)L; { const int q = nwg / NXCD, r = nwg % NXCD, xcd = wgid % NXCD, off = wgid / NXCD; wgid = (xcd < r ? xcd * (q + 1) : r * (q + 1) + (xcd - r) * q) + off; }
        const int nig = WGM * nN, gid = wgid / nig, fm = gid * WGM, gsz = (nM - fm) < WGM ? (nM - fm) : WGM;
        u.pm = fm + ((wgid % nig) % gsz); u.pn = (wgid % nig) / gsz; return true;
    }
    __device__ __forceinline__ void a_ready(const Unit&) const {}
    __device__ __forceinline__ void done(const Unit&) const {}
};


__device__ __forceinline__ unsigned cvt_pk_bf16(float lo, float hi) { unsigned r; asm volatile("v_cvt_pk_bf16_f32 %0, %1, %2" : "=v"(r) : "v"(lo), "v"(hi)); return r; }
struct EpiF32 {
    static constexpr bool PERM = false, AFTER_DRAIN = false;
    float* C; int ldc;
    __device__ __forceinline__ void operator()(const f32x4 (&acc)[2][2][4][2], const Unit& u, int wr, int wc, int fr, int fq) const {
        const int row0 = u.pm * BM + wr * 64 + fr, col0 = u.pn * BM + wc * 32 + 4 * fq;
#pragma unroll
        for (int ai = 0; ai < 2; ++ai)
#pragma unroll
            for (int m = 0; m < 4; ++m) { float* rowp = C + (size_t)(row0 + ai * HALF + m * 16) * ldc + col0;
#pragma unroll
                for (int bj = 0; bj < 2; ++bj)
#pragma unroll
                    for (int n = 0; n < 2; ++n) *(f32x4*)(rowp + bj * HALF + n * 16) = acc[ai][bj][m][n]; }
    }
};
template <int ACT  > struct EpiBf16 {
    static constexpr bool PERM = true, AFTER_DRAIN = false;
    bf16_t* O; int ldc;
    __device__ __forceinline__ void operator()(const f32x4 (&acc)[2][2][4][2], const Unit& u, int wr, int wc, int fr, int fq) const {
        const int row0 = u.pm * BM + wr * 64 + fr; const int col0 = u.pn * BM + wc * 32 + 8 * fq;
#pragma unroll
        for (int ai = 0; ai < 2; ++ai)
#pragma unroll
            for (int m = 0; m < 4; ++m) { bf16_t* rowp = O + (size_t)(row0 + ai * HALF + m * 16) * ldc + col0;
#pragma unroll
                for (int bj = 0; bj < 2; ++bj) { f32x4 v0 = acc[ai][bj][m][0], v1 = acc[ai][bj][m][1];
                    if (ACT == 1) {
#pragma unroll
                        for (int e = 0; e < 4; ++e) { const float a = fmaxf(v0[e], 0.f), b = fmaxf(v1[e], 0.f); v0[e] = a * a; v1[e] = b * b; } }
                    u32x4 w; w.x = cvt_pk_bf16(v0[0], v0[1]); w.y = cvt_pk_bf16(v0[2], v0[3]); w.z = cvt_pk_bf16(v1[0], v1[1]); w.w = cvt_pk_bf16(v1[2], v1[3]);
                    *(u32x4*)(rowp + bj * HALF) = w; } }
    }
};

template <class Epi, class Sched, bool ALIGN_EPI = false, bool SP2 = false>
__device__ __forceinline__ void gemm_phase(PG8_LAS unsigned char* lds, const Gemm g, const Sched& S, const Epi& E) {
    const int tid = threadIdx.x, wid = __builtin_amdgcn_readfirstlane(tid >> 6), lane = tid & 63, wr = wid >> 2, wc = wid & 3, fr = lane & 15, fq = lane >> 4;
    const int K = g.K, nt = K / BK;
    unsigned voffA[2], voffB[2];
#pragma unroll
    for (int i = 0; i < 2; ++i) { int R, C; stage_rc(tid * 16 + i * 8192, R, C); const int Rb = Epi::PERM ? ((R & ~31) + perm32(R & 31)) : R;
        voffA[i] = (unsigned)(R * K + C) * 2u; voffB[i] = (unsigned)(Rb * K + C) * 2u; }
    const size_t kstep = (size_t)(BK * 2);
    const size_t hstep = (size_t)HALF * K * 2;
    const size_t tstep = 2 * hstep;
    const unsigned ldsw = (unsigned)wid * 1024u;
    const int aoff = lds_byte(wr * 64 + fr, fq * 8), boff = lds_byte(wc * 32 + fr, fq * 8);
#define PG8_SA(b, h) (((b) * 2 + (h)) * HTB)
#define PG8_SB(b, h) ((4 + (b) * 2 + (h)) * HTB)
#define PG8_STAGE(bufoff, gbase, voff) do { _Pragma("unroll") for (int _i = 0; _i < 2; ++_i) \
        __builtin_amdgcn_global_load_lds((const unsigned*)((const char*)(gbase) + (voff)[_i]), (PG8_LAS unsigned*)(lds + (bufoff) + ldsw + _i * 8192), 16, 0, 0); } while (0)
#define PG8_LDA(dst, b, h) do { _Pragma("unroll") for (int m = 0; m < 4; ++m) _Pragma("unroll") for (int k = 0; k < 2; ++k) dst[m][k] = *(const PG8_LAS bf16x8*)(lds + PG8_SA(b, h) + aoff + m * 2048 + k * 1024); } while (0)
#define PG8_LDB(dst, b, h) do { _Pragma("unroll") for (int n = 0; n < 2; ++n) _Pragma("unroll") for (int k = 0; k < 2; ++k) dst[n][k] = *(const PG8_LAS bf16x8*)(lds + PG8_SB(b, h) + boff + n * 2048 + k * 1024); } while (0)
#define PG8_MMA(ai, bj, At, Bt) do { __builtin_amdgcn_s_setprio(1); _Pragma("unroll") for (int m = 0; m < 4; ++m) _Pragma("unroll") for (int n = 0; n < 2; ++n) _Pragma("unroll") for (int k = 0; k < 2; ++k) \
        acc[ai][bj][m][n] = __builtin_amdgcn_mfma_f32_16x16x32_bf16(Bt[n][k], At[m][k], acc[ai][bj][m][n], 0, 0, 0); __builtin_amdgcn_s_setprio(0); } while (0)
#define PG8_WAIT_V(n) asm volatile("s_waitcnt vmcnt(" #n ")" ::: "memory")
#define PG8_WAIT_L(n) asm volatile("s_waitcnt lgkmcnt(" #n ")" ::: "memory")
#define PG8_BAR __builtin_amdgcn_s_barrier()
#define PG8_SCHED __builtin_amdgcn_sched_barrier(0)
    Unit cur, nxt; int ui = 0;
    if (!S.next(0, cur)) return;
    f32x4 acc[2][2][4][2];
#pragma unroll
    for (int a = 0; a < 2; ++a)
#pragma unroll
        for (int b = 0; b < 2; ++b)
#pragma unroll
            for (int m = 0; m < 4; ++m)
#pragma unroll
                for (int n = 0; n < 2; ++n) acc[a][b][m][n] = (f32x4){0.f, 0.f, 0.f, 0.f};
    bf16x8 At[4][2], B0[2][2], B1[2][2];
    const char* cA = (const char*)g.A + (size_t)cur.pm * tstep; const char* cB = (const char*)g.Bt + (size_t)cur.pn * tstep;
    S.a_ready(cur);
    if constexpr (SP2) {
        PG8_STAGE(PG8_SB(0, 0), cB, voffB); PG8_STAGE(PG8_SB(0, 1), cB + hstep, voffB); PG8_STAGE(PG8_SA(0, 0), cA, voffA); PG8_STAGE(PG8_SA(0, 1), cA + hstep, voffA);
        if (wr == 1) PG8_BAR;
        PG8_WAIT_V(2); PG8_BAR;
        PG8_STAGE(PG8_SB(1, 0), cB + kstep, voffB); PG8_STAGE(PG8_SA(1, 0), cA + kstep, voffA); PG8_STAGE(PG8_SB(1, 1), cB + hstep + kstep, voffB);
        PG8_WAIT_V(6); PG8_BAR;
    } else {
        PG8_STAGE(PG8_SB(0, 0), cB, voffB); PG8_STAGE(PG8_SA(0, 0), cA, voffA); PG8_STAGE(PG8_SB(0, 1), cB + hstep, voffB); PG8_STAGE(PG8_SA(0, 1), cA + hstep, voffA);
        if (wr == 1) PG8_BAR;
        PG8_WAIT_V(4); PG8_BAR;
        PG8_STAGE(PG8_SB(1, 0), cB + kstep, voffB); PG8_STAGE(PG8_SA(1, 0), cA + kstep, voffA); PG8_STAGE(PG8_SB(1, 1), cB + hstep + kstep, voffB);
        PG8_WAIT_V(6); PG8_BAR;
    }
    for (;;) {
        const bool has_next = S.next(ui + 1, nxt);
        const char* nA = has_next ? (const char*)g.A + (size_t)nxt.pm * tstep : cA; const char* nB = has_next ? (const char*)g.Bt + (size_t)nxt.pn * tstep : cB;
        for (int t = 0; t < nt; t += 2) {
            const bool last = (t == nt - 2);
            const char* a1 = cA + (size_t)(t + 1) * kstep;
            const char* a2 = last ? nA : cA + (size_t)(t + 2) * kstep; const char* b2 = last ? nB : cB + (size_t)(t + 2) * kstep;
            const char* a3 = a2 + kstep; const char* b3 = b2 + kstep;
            if (last && has_next) S.a_ready(nxt);
            if constexpr (SP2) {
            PG8_LDB(B0, 0, 0); PG8_LDB(B1, 0, 1); PG8_SCHED; PG8_LDA(At, 0, 0); PG8_STAGE(PG8_SA(1, 1), a1 + hstep, voffA);
            PG8_WAIT_V(8); PG8_WAIT_L(0); PG8_BAR; PG8_MMA(0, 0, At, B0); PG8_MMA(0, 1, At, B1); PG8_BAR; PG8_SCHED;
            PG8_LDA(At, 0, 1); PG8_STAGE(PG8_SB(0, 0), b2, voffB); PG8_STAGE(PG8_SB(0, 1), b2 + hstep, voffB); PG8_STAGE(PG8_SA(0, 0), a2, voffA);
            PG8_WAIT_V(8); PG8_WAIT_L(0); PG8_BAR; PG8_MMA(1, 0, At, B0); PG8_MMA(1, 1, At, B1); PG8_BAR; PG8_SCHED;
            PG8_LDB(B0, 1, 0); PG8_LDB(B1, 1, 1); PG8_SCHED; PG8_LDA(At, 1, 0); PG8_STAGE(PG8_SA(0, 1), a2 + hstep, voffA);
            PG8_WAIT_V(8); PG8_WAIT_L(0); PG8_BAR; PG8_MMA(0, 0, At, B0); PG8_MMA(0, 1, At, B1); PG8_BAR; PG8_SCHED;
            PG8_LDA(At, 1, 1); PG8_STAGE(PG8_SB(1, 0), b3, voffB); PG8_STAGE(PG8_SB(1, 1), b3 + hstep, voffB); PG8_STAGE(PG8_SA(1, 0), a3, voffA);
            PG8_WAIT_V(8); PG8_WAIT_L(0); PG8_BAR; PG8_MMA(1, 0, At, B0); PG8_MMA(1, 1, At, B1); PG8_BAR; PG8_SCHED;
            } else {
            PG8_LDB(B0, 0, 0); PG8_SCHED; PG8_LDA(At, 0, 0); PG8_STAGE(PG8_SA(1, 1), a1 + hstep, voffA);
            PG8_WAIT_L(8); PG8_BAR; PG8_WAIT_L(0); PG8_MMA(0, 0, At, B0); PG8_BAR; PG8_SCHED;
            PG8_LDB(B1, 0, 1); PG8_STAGE(PG8_SB(0, 0), b2, voffB);
            PG8_BAR; PG8_WAIT_L(0); PG8_MMA(0, 1, At, B1); PG8_BAR;
            PG8_LDA(At, 0, 1); PG8_STAGE(PG8_SA(0, 0), a2, voffA);
            PG8_BAR; PG8_WAIT_L(0); PG8_MMA(1, 0, At, B0); PG8_BAR; PG8_SCHED;
            PG8_STAGE(PG8_SB(0, 1), b2 + hstep, voffB);
            PG8_WAIT_V(6); PG8_BAR; PG8_MMA(1, 1, At, B1); PG8_BAR;
            PG8_LDB(B0, 1, 0); PG8_SCHED; PG8_LDA(At, 1, 0); PG8_STAGE(PG8_SA(0, 1), a2 + hstep, voffA);
            PG8_WAIT_L(8); PG8_BAR; PG8_WAIT_L(0); PG8_MMA(0, 0, At, B0); PG8_BAR; PG8_SCHED;
            PG8_LDB(B1, 1, 1); PG8_STAGE(PG8_SB(1, 0), b3, voffB);
            PG8_BAR; PG8_WAIT_L(0); PG8_MMA(0, 1, At, B1); PG8_BAR;
            PG8_LDA(At, 1, 1); PG8_STAGE(PG8_SA(1, 0), a3, voffA);
            PG8_BAR; PG8_WAIT_L(0); PG8_MMA(1, 0, At, B0); PG8_BAR; PG8_SCHED;
            PG8_STAGE(PG8_SB(1, 1), b3 + hstep, voffB);
            PG8_WAIT_V(6); PG8_BAR; PG8_MMA(1, 1, At, B1); PG8_BAR;
            }
        }
        if constexpr (ALIGN_EPI) { if (wr == 0) PG8_BAR; }
        if constexpr (!Epi::AFTER_DRAIN) { E(acc, cur, wr, wc, fr, fq); S.done(cur); }
        if (!has_next) break;
#pragma unroll
        for (int a = 0; a < 2; ++a)
#pragma unroll
            for (int b = 0; b < 2; ++b)
#pragma unroll
                for (int m = 0; m < 4; ++m)
#pragma unroll
                    for (int n = 0; n < 2; ++n) acc[a][b][m][n] = (f32x4){0.f, 0.f, 0.f, 0.f};
        cur = nxt; cA = nA; cB = nB; ++ui;
        if constexpr (ALIGN_EPI) { if (wr == 1) PG8_BAR; }
    }
    PG8_WAIT_V(0);
    if constexpr (!ALIGN_EPI) { if (wr == 0) PG8_BAR; }
    PG8_BAR;
    if constexpr (Epi::AFTER_DRAIN) { E.fused(acc, cur, wr, wc, fr, fq, lds, wid, lane); S.done(cur); }
#undef PG8_SA
#undef PG8_SB
#undef PG8_STAGE
#undef PG8_LDA
#undef PG8_LDB
#undef PG8_MMA
#undef PG8_WAIT_V
#undef PG8_WAIT_L
#undef PG8_BAR
#undef PG8_SCHED
}
}
#define GAS __attribute__((address_space(1)))
#define LAS __attribute__((address_space(3)))
typedef unsigned short bf16;
typedef unsigned v4u __attribute__((ext_vector_type(4)));
typedef float f32x4 __attribute__((ext_vector_type(4)));
typedef short bf16x8 __attribute__((ext_vector_type(8)));
typedef GAS unsigned gu32;
typedef GAS unsigned long long gu64;
#define RLX_AGENT __ATOMIC_RELAXED, __HIP_MEMORY_SCOPE_AGENT
#define LDS_WAIT() asm volatile("s_waitcnt lgkmcnt(0)" ::: "memory")
#define VM_WAIT() asm volatile("s_waitcnt vmcnt(0)" ::: "memory")
__device__ __forceinline__ unsigned long long rt() { return __builtin_amdgcn_s_memrealtime(); }
__device__ __forceinline__ unsigned f2bf(float f) { unsigned u = __builtin_bit_cast(unsigned, f); return (u + 0x7fffu + ((u >> 16) & 1u)) >> 16; }
__device__ __forceinline__ unsigned pk2(float lo, float hi) { return f2bf(lo) | (f2bf(hi) << 16); }

#define XB_TMO      128
#define XB_XCNT(j)  (256  + 64 * (j))
#define XB_XSUB(j)  (1280 + 64 * (j))
#define XB_XGEN(j)  (2304 + 64 * (j))
#define XB_TOP      3328
#define XB_TOPGEN   3392
#define XCD_BAR_WORDS 3456
#define XB_SPIN_CAP (1u << 18)

__device__ __forceinline__ unsigned xb_ld(unsigned* p)              { return __hip_atomic_load(p, __ATOMIC_RELAXED, __HIP_MEMORY_SCOPE_AGENT); }
__device__ __forceinline__ unsigned xb_add(unsigned* p, unsigned v) { return __hip_atomic_fetch_add(p, v, __ATOMIC_RELAXED, __HIP_MEMORY_SCOPE_AGENT); }
__device__ __forceinline__ unsigned xb_xcc_id() { return (unsigned)__builtin_amdgcn_s_getreg((3 << 11) | 20) & 0xFu; }
#define XB_SPIN(cond, bar) do { unsigned _sp = 0; while (cond) { __builtin_amdgcn_s_sleep(1); \
    if ((++_sp & 255u) == 0u) { if (xb_ld(&(bar)[XB_TMO])) break; if (_sp > XB_SPIN_CAP) { atomicAdd(&(bar)[XB_TMO], 1u); break; } } } } while (0)

struct XcdBarrier {
    unsigned* bar; unsigned x;
    volatile LAS unsigned* st;
};

__device__ __forceinline__ XcdBarrier xcd_barrier_post(unsigned* bar, volatile LAS unsigned* st) {
    XcdBarrier b; b.bar = bar; b.x = xb_xcc_id(); b.st = st;
    if (threadIdx.x == 0) (void)xb_add(&bar[XB_XCNT(b.x)], 1u);
    return b;
}
__device__ __forceinline__ void xcd_barrier_complete(unsigned* bar, unsigned x, unsigned& nloc, unsigned& nx) {
    const unsigned G = gridDim.x * gridDim.y * gridDim.z;
    unsigned sum, cnt, mine, sp = 0u;
    for (;;) {
        sum = 0u; cnt = 0u; mine = 0u;
#pragma unroll
        for (unsigned j = 0; j < 16; ++j) { const unsigned c = xb_ld(&bar[XB_XCNT(j)]); sum += c; cnt += (c > 0u) ? 1u : 0u; mine = (j == x) ? c : mine; }
        if (sum == G) break;
        __builtin_amdgcn_s_sleep(1);
        if ((++sp & 255u) == 0u) { if (xb_ld(&bar[XB_TMO])) break; if (sp > XB_SPIN_CAP) { atomicAdd(&bar[XB_TMO], 1u); break; } }
    }
    nloc = mine > 0u ? mine : 1u; nx = cnt > 0u ? cnt : 1u;
}

__device__ __forceinline__ void xcd_barrier(const XcdBarrier& b) {
    asm volatile("s_waitcnt vmcnt(0)" ::: "memory");
    __syncthreads();
    if (threadIdx.x == 0) {
        unsigned* bar = b.bar;
        __builtin_amdgcn_s_waitcnt(0);
        unsigned nloc = b.st[0], nx = b.st[1];
        if (nloc == 0u) { xcd_barrier_complete(bar, b.x, nloc, nx); b.st[0] = nloc; b.st[1] = nx; }
        const unsigned old = xb_add(&bar[XB_XSUB(b.x)], 1u);
        const unsigned gen = old / nloc;
        if (old + 1u == (gen + 1u) * nloc) {
            __builtin_amdgcn_fence(__ATOMIC_RELEASE, "agent");
            asm volatile("s_waitcnt vmcnt(0)" ::: "memory");
            const unsigned og = xb_add(&bar[XB_TOP], 1u);
            const unsigned tg = og / nx;
            if (og + 1u == (tg + 1u) * nx) xb_add(&bar[XB_TOPGEN], 1u);
            else XB_SPIN(xb_ld(&bar[XB_TOPGEN]) == tg, bar);
            __builtin_amdgcn_fence(__ATOMIC_ACQUIRE, "agent");
            xb_add(&bar[XB_XGEN(b.x)], 1u);
            asm volatile("s_waitcnt vmcnt(0)" ::: "memory");
        } else {
            XB_SPIN(xb_ld(&bar[XB_XGEN(b.x)]) == gen, bar);
            __builtin_amdgcn_fence(__ATOMIC_ACQUIRE, "agent");
            asm volatile("s_waitcnt vmcnt(0)" ::: "memory");
        }
    }
    __syncthreads();
}
constexpr int NWAVES = 8;
constexpr int DM = 1024, BATCH = 8, SEQ = 4096, M = BATCH * SEQ, FF = 4096, INC = 2336, NP = 2560;
constexpr float EPS = 1e-6f;
constexpr int C_GQ = 0, C_GK = 256, C_GV = 512, C_GG = 1024, C_Z = 1536, C_SQ = 1568, C_SK = 2080, C_SV = 2208;
constexpr int P_GQ = 0, P_GK = 64, P_GV = 128, P_GG = 256, P_GH = 384, P_SQ = 1536, P_SK = 2048, P_SV = 2176, P_Z = 2304;
__host__ __device__ constexpr int src_col32(int jb) {
    return jb < 48 ? ((jb % 12) < 2 ? C_GQ + 64 * (jb / 12) + 32 * (jb % 12)
                    : (jb % 12) < 4 ? C_GK + 64 * (jb / 12) + 32 * ((jb % 12) - 2)
                    : (jb % 12) < 8 ? C_GV + 128 * (jb / 12) + 32 * ((jb % 12) - 4)
                                    : C_GG + 128 * (jb / 12) + 32 * ((jb % 12) - 8))
         : jb < 64 ? C_SQ + 32 * (jb - 48) : jb < 68 ? C_SK + 32 * (jb - 64) : jb < 72 ? C_SV + 32 * (jb - 68) : jb == 72 ? C_Z : -1;
}
constexpr size_t MiB = 1u << 20;
constexpr size_t WS_CTL = 0, CTL_ZERO_BYTES = 64 * 1024;
constexpr size_t WS_WIN = 2 * MiB, WS_WO = 8 * MiB, WS_WUP = 10 * MiB, WS_WDN = 18 * MiB;
constexpr size_t WS_U = 32 * MiB;
constexpr size_t WS_PROJ = 96 * MiB;
constexpr size_t WS_MIX = 256 * MiB;
constexpr size_t WS_H = 96 * MiB;
constexpr size_t WS_T = 352 * MiB;
constexpr size_t WS_END = 512 * MiB;
constexpr int CW_BAR = 1024;

constexpr int RING_OFF = 0, RING_BYTES = 131072;
constexpr int LDSCTL_OFF = RING_BYTES, MISC_OFF = LDSCTL_OFF + 320;
constexpr int LDS_BYTES = 147456;

__device__ __forceinline__ float bf2f(unsigned short v) { return __uint_as_float((unsigned)v << 16); }
__device__ __forceinline__ float wave_sum(float v) {
#pragma unroll
    for (int o = 1; o < 64; o <<= 1) v += __shfl_xor(v, o);
    return v;
}
__device__ __forceinline__ void transpose_item(const float* W, int ldw, int K, int src_n0, bf16* WT, int dst_row0, int k0, LAS float* scr, int lane) {
    if (src_n0 >= 0) {
#pragma unroll 8
        for (int i = 0; i < 32; ++i) { const int kk = 2 * i + (lane >> 5); scr[kk * 33 + (lane & 31)] = W[(size_t)(k0 + kk) * ldw + src_n0 + (lane & 31)]; }
    } else {
#pragma unroll 8
        for (int i = 0; i < 32; ++i) { const int kk = 2 * i + (lane >> 5); scr[kk * 33 + (lane & 31)] = 0.f; }
    }
    LDS_WAIT(); asm volatile("" ::: "memory");
    const int c = lane & 7;
#pragma unroll
    for (int j = 0; j < 4; ++j) { const int n = (lane >> 3) + 8 * j; const LAS float* s = scr + (8 * c) * 33 + n;
        v4u o; o.x = pk2(s[0 * 33], s[1 * 33]); o.y = pk2(s[2 * 33], s[3 * 33]); o.z = pk2(s[4 * 33], s[5 * 33]); o.w = pk2(s[6 * 33], s[7 * 33]);
        *(GAS v4u*)(WT + (size_t)(dst_row0 + n) * K + k0 + 8 * c) = o; }
    LDS_WAIT(); asm volatile("" ::: "memory");
}
__device__ __forceinline__ void rms_row_to_bf16(const float* xrow, const float* g, bf16* orow, int lane) {
    const GAS f32x4* xr = (const GAS f32x4*)xrow + lane;
    f32x4 v[4]; float s = 0.f;
#pragma unroll
    for (int j = 0; j < 4; ++j) { v[j] = xr[64 * j]; s += (v[j].x * v[j].x + v[j].y * v[j].y) + (v[j].z * v[j].z + v[j].w * v[j].w); }
    const float rs = 1.f / sqrtf(wave_sum(s) * (1.f / DM) + EPS);
    GAS unsigned long long* o8 = (GAS unsigned long long*)orow + lane;
#pragma unroll
    for (int j = 0; j < 4; ++j) { const f32x4 gg = ((const GAS f32x4*)g)[lane + 64 * j];
        o8[64 * j] = (unsigned long long)pk2(v[j].x * rs * gg.x, v[j].y * rs * gg.y) | ((unsigned long long)pk2(v[j].z * rs * gg.z, v[j].w * rs * gg.w) << 32); }
}
__device__ __forceinline__ float log_sigmoid(float x) { return fminf(x, 0.f) - log1pf(expf(-fabsf(x))); }
__device__ __forceinline__ int t5_bucket(int rel) {
    const int n = rel < 0 ? -rel : rel;
    const int large = 8 + (n >= 12) + (n >= 16) + (n >= 23) + (n >= 32) + (n >= 46) + (n >= 64) + (n >= 91);
    return (rel > 0 ? 16 : 0) + (n < 8 ? n : large);
}

__device__ __forceinline__ void gla_simple_task(int task, const bf16* proj, const float* wgf, const float* bgf, const float* wgb, const float* bgb, float* of, float* ob, int lane) {
    int id = task; const int es = id & 15; id >>= 4; const int dir = id & 1; id >>= 1; const int h = id & 3; const int b = id >> 2;
    const float* wg = dir ? wgb : wgf; const float* bg = dir ? bgb : bgf; float* o = dir ? ob : of;
    float w[16];
#pragma unroll
    for (int r = 0; r < 16; ++r) w[r] = wg[r * 256 + h * 64 + lane];
    const float bias = bg[h * 64 + lane];
    float S[8];
#pragma unroll
    for (int e = 0; e < 8; ++e) S[e] = 0.f;
    for (int i = 0; i < SEQ; ++i) {
        const int t = dir ? (SEQ - 1 - i) : i;
        const bf16* pr = proj + (size_t)(b * SEQ + t) * NP;
        float pre = bias;
#pragma unroll
        for (int r = 0; r < 16; ++r) pre = fmaf(bf2f(pr[P_Z + dir * 16 + r]), w[r], pre);
        const float a = expf(log_sigmoid(pre) * (1.f / 16.f));
        const float q = bf2f(pr[P_GH * h + P_GQ + lane]) * 0.125f, k = bf2f(pr[P_GH * h + P_GK + lane]);
        float part[8];
#pragma unroll
        for (int e = 0; e < 8; ++e) { const float v = bf2f(pr[P_GH * h + P_GV + es * 8 + e]); S[e] = fmaf(a, S[e], k * v); part[e] = q * S[e]; }
#pragma unroll
        for (int e = 0; e < 8; ++e) part[e] = wave_sum(part[e]);
        if (lane < 8) { float v = part[0];
#pragma unroll
            for (int e = 1; e < 8; ++e) v = (lane == e) ? part[e] : v;
            o[(size_t)(b * SEQ + t) * 512 + h * 128 + es * 8 + lane] = v; }
    }
}
__device__ __forceinline__ void gla_post_task(int w, const float* of, const float* ob, const bf16* proj, const float* gn, bf16* mix, int lane) {
    const int tok = w >> 2, h = w & 3;
    const size_t off = (size_t)tok * 512 + h * 128;
    const float v0 = of[off + lane] + ob[off + lane], v1 = of[off + 64 + lane] + ob[off + 64 + lane];
    const float rs = 1.f / sqrtf(wave_sum(v0 * v0 + v1 * v1) * (1.f / 128.f) + EPS);
    const float g0 = bf2f(proj[(size_t)tok * NP + P_GH * h + P_GG + lane]), g1 = bf2f(proj[(size_t)tok * NP + P_GH * h + P_GG + 64 + lane]);
    mix[(size_t)tok * DM + h * 128 + lane] = (bf16)f2bf(v0 * rs * gn[lane] * (g0 / (1.f + expf(-g0))));
    mix[(size_t)tok * DM + h * 128 + 64 + lane] = (bf16)f2bf(v1 * rs * gn[64 + lane] * (g1 / (1.f + expf(-g1))));
}
__device__ __forceinline__ void swa_simple_task(int w, const bf16* proj, const float* sink, const float* relb, bf16* mix, LAS float* scr, int lane) {
    const int tok = w >> 3, qh = w & 7, kvh = qh >> 2, b = tok / SEQ, i = tok % SEQ;
    LAS float* qs = scr; LAS float* ps = scr + 64;
    qs[lane] = bf2f(proj[(size_t)tok * NP + P_SQ + qh * 64 + lane]);
    LDS_WAIT(); asm volatile("" ::: "memory");
    float lg[5]; float mx = sink[qh];
#pragma unroll
    for (int c = 0; c < 5; ++c) {
        const int jj = c * 64 + lane, j = i - 128 + jj;
        float l = -1e30f;
        if (jj <= 256 && j >= 0 && j < SEQ) {
            const bf16* kr = proj + (size_t)(b * SEQ + j) * NP + P_SK + kvh * 64;
            float dot = 0.f;
            for (int d = 0; d < 64; ++d) dot = fmaf(qs[d], bf2f(kr[d]), dot);
            l = dot * 0.125f + relb[t5_bucket(j - i) * 8 + qh];
        }
        lg[c] = l; mx = fmaxf(mx, l);
    }
#pragma unroll
    for (int o = 1; o < 64; o <<= 1) mx = fmaxf(mx, __shfl_xor(mx, o));
    float den = 0.f;
#pragma unroll
    for (int c = 0; c < 5; ++c) { const float p = (lg[c] > -1e29f) ? expf(lg[c] - mx) : 0.f; ps[c * 64 + lane] = p; den += p; }
    den = wave_sum(den) + expf(sink[qh] - mx);
    LDS_WAIT(); asm volatile("" ::: "memory");
    float acc = 0.f;
    for (int jj = 0; jj <= 256; ++jj) {
        const int j = i - 128 + jj;
        if (j < 0 || j >= SEQ) continue;
        acc = fmaf(ps[jj], bf2f(proj[(size_t)(b * SEQ + j) * NP + P_SV + kvh * 64 + lane]), acc);
    }
    mix[(size_t)tok * DM + 512 + qh * 64 + lane] = (bf16)f2bf(acc / den);
    LDS_WAIT(); asm volatile("" ::: "memory");
}
__device__ __forceinline__ void norm_mid_row(const float* trow, const float* xrow, const float* g1, const float* g2, float* orow, bf16* xnrow, int lane) {
    f32x4 t[4], h[4]; float s = 0.f;
#pragma unroll
    for (int j = 0; j < 4; ++j) { t[j] = ((const GAS f32x4*)trow)[lane + 64 * j]; s += (t[j].x * t[j].x + t[j].y * t[j].y) + (t[j].z * t[j].z + t[j].w * t[j].w); }
    const float rs = 1.f / sqrtf(wave_sum(s) * (1.f / DM) + EPS); float s2 = 0.f;
#pragma unroll
    for (int j = 0; j < 4; ++j) { const f32x4 gg = ((const GAS f32x4*)g1)[lane + 64 * j], xx = ((const GAS f32x4*)xrow)[lane + 64 * j];
        h[j] = xx + t[j] * rs * gg; ((GAS f32x4*)orow)[lane + 64 * j] = h[j]; s2 += (h[j].x * h[j].x + h[j].y * h[j].y) + (h[j].z * h[j].z + h[j].w * h[j].w); }
    const float rs2 = 1.f / sqrtf(wave_sum(s2) * (1.f / DM) + EPS);
    GAS unsigned long long* o8 = (GAS unsigned long long*)xnrow + lane;
#pragma unroll
    for (int j = 0; j < 4; ++j) { const f32x4 gg = ((const GAS f32x4*)g2)[lane + 64 * j];
        o8[64 * j] = (unsigned long long)pk2(h[j].x * rs2 * gg.x, h[j].y * rs2 * gg.y) | ((unsigned long long)pk2(h[j].z * rs2 * gg.z, h[j].w * rs2 * gg.w) << 32); }
}
__device__ __forceinline__ void norm_final_row(const float* trow, const float* g, float* orow, int lane) {
    f32x4 t[4]; float s = 0.f;
#pragma unroll
    for (int j = 0; j < 4; ++j) { t[j] = ((const GAS f32x4*)trow)[lane + 64 * j]; s += (t[j].x * t[j].x + t[j].y * t[j].y) + (t[j].z * t[j].z + t[j].w * t[j].w); }
    const float rs = 1.f / sqrtf(wave_sum(s) * (1.f / DM) + EPS);
#pragma unroll
    for (int j = 0; j < 4; ++j) { const f32x4 gg = ((const GAS f32x4*)g)[lane + 64 * j]; GAS f32x4* op = (GAS f32x4*)orow + lane + 64 * j; *op = *op + t[j] * rs * gg; }
}

struct Args { const float* in[16]; float* out; unsigned char* ws; };
__global__ void __launch_bounds__(NWAVES * 64, 2) fwd_megakernel(Args args) {
    extern __shared__ __attribute__((aligned(16))) unsigned char lds[];
    LAS unsigned char* L = (LAS unsigned char*)lds;
    volatile LAS unsigned* MISC = (volatile LAS unsigned*)(L + MISC_OFF);
    const int tid = threadIdx.x, lane = tid & 63, wave = __builtin_amdgcn_readfirstlane(tid >> 6);
    const int G = gridDim.x; const int bx = blockIdx.x; const int vcu = (G % 8 == 0) ? (bx % 8) * (G / 8) + bx / 8 : bx;
    const int gw = vcu * NWAVES + wave, NGW = G * NWAVES;
    unsigned char* ws = args.ws;
    gu32* ctl = (gu32*)(ws + WS_CTL);
    const float* x = args.in[0]; const float* g_pre = args.in[1]; const float* w_in = args.in[2];
    const float* wgf = args.in[3]; const float* bgf = args.in[4]; const float* wgb = args.in[5]; const float* bgb = args.in[6];
    const float* gla_norm = args.in[7]; const float* sink = args.in[8]; const float* relb = args.in[9];
    const float* w_out = args.in[10]; const float* g_post = args.in[11]; const float* g_mlp_pre = args.in[12];
    const float* w_up = args.in[13]; const float* w_down = args.in[14]; const float* g_mlp_post = args.in[15];
    float* out = args.out;
    bf16* Win_t = (bf16*)(ws + WS_WIN); bf16* Wo_t = (bf16*)(ws + WS_WO); bf16* Wup_t = (bf16*)(ws + WS_WUP); bf16* Wdn_t = (bf16*)(ws + WS_WDN);
    bf16* U = (bf16*)(ws + WS_U); bf16* PROJ = (bf16*)(ws + WS_PROJ); bf16* MIX = (bf16*)(ws + WS_MIX); bf16* HB = (bf16*)(ws + WS_H);
    float* T = (float*)(ws + WS_T); float* OF = T; float* OB = T + (size_t)M * 512;

    for (int u = tid; u < (LDS_BYTES - LDSCTL_OFF) / 4; u += NWAVES * 64) ((LAS unsigned*)(L + LDSCTL_OFF))[u] = 0u;
    __syncthreads();
    XcdBarrier bar = xcd_barrier_post((unsigned*)(ctl + CW_BAR), MISC + 8);

    {
        LAS float* scr = (LAS float*)(L + RING_OFF + wave * 16384);
        constexpr int I_IN = 16 * (NP / 32), I_O = 16 * 32, I_UP = 16 * 128, I_DN = 64 * 32, NITEMS = I_IN + I_O + I_UP + I_DN;
        for (int it = gw; it < NITEMS; it += NGW) {
            int r = it;
            if (r < I_IN) { const int kb = r / (NP / 32), jb = r % (NP / 32); transpose_item(w_in, INC, DM, src_col32(jb), Win_t, 32 * jb, 64 * kb, scr, lane); continue; } r -= I_IN;
            if (r < I_O) { const int kb = r / 32, jb = r % 32; transpose_item(w_out, DM, DM, 32 * jb, Wo_t, 32 * jb, 64 * kb, scr, lane); continue; } r -= I_O;
            if (r < I_UP) { const int kb = r / 128, jb = r % 128; transpose_item(w_up, FF, DM, 32 * jb, Wup_t, 32 * jb, 64 * kb, scr, lane); continue; } r -= I_UP;
            { const int kb = r / 32, jb = r % 32; transpose_item(w_down, DM, FF, 32 * jb, Wdn_t, 32 * jb, 64 * kb, scr, lane); }
        }
        for (int m = gw; m < M; m += NGW) rms_row_to_bf16(x + (size_t)m * DM, g_pre, U + (size_t)m * DM, lane);
    }
    xcd_barrier(bar);

    {
        pg8::Gemm g{U, Win_t, M, NP, DM}; pg8::StaticOrder S; S.init(M, NP, G, bx);
        pg8::EpiBf16<0> E{PROJ, NP};
        pg8::gemm_phase<pg8::EpiBf16<0>, pg8::StaticOrder, true, true>(L + RING_OFF, g, S, E);
    }
    xcd_barrier(bar);

    if ((gw & 1) == 0) gla_simple_task(gw >> 1, PROJ, wgf, bgf, wgb, bgb, OF, OB, lane);
    xcd_barrier(bar);
    for (int w = gw; w < M * 4; w += NGW) gla_post_task(w, OF, OB, PROJ, gla_norm, MIX, lane);
    { LAS float* scr = (LAS float*)(L + RING_OFF + wave * 2048);
      for (int w = gw; w < M * 8; w += NGW) swa_simple_task(w, PROJ, sink, relb, MIX, scr, lane); }
    xcd_barrier(bar);

    {
        pg8::Gemm g{MIX, Wo_t, M, DM, DM}; pg8::StaticOrder S; S.init(M, DM, G, bx);
        pg8::EpiF32 E{T, DM};
        pg8::gemm_phase<pg8::EpiF32, pg8::StaticOrder, true, true>(L + RING_OFF, g, S, E);
    }
    xcd_barrier(bar);
    for (int m = gw; m < M; m += NGW) norm_mid_row(T + (size_t)m * DM, x + (size_t)m * DM, g_post, g_mlp_pre, out + (size_t)m * DM, U + (size_t)m * DM, lane);
    xcd_barrier(bar);

    {
        pg8::Gemm g{U, Wup_t, M, FF, DM}; pg8::StaticOrder S; S.init(M, FF, G, bx);
        pg8::EpiBf16<1> E{HB, FF};
        pg8::gemm_phase<pg8::EpiBf16<1>, pg8::StaticOrder, true, true>(L + RING_OFF, g, S, E);
    }
    xcd_barrier(bar);

    {
        pg8::Gemm g{HB, Wdn_t, M, DM, FF}; pg8::StaticOrder S; S.init(M, DM, G, bx);
        pg8::EpiF32 E{T, DM};
        pg8::gemm_phase<pg8::EpiF32, pg8::StaticOrder, true, true>(L + RING_OFF, g, S, E);
    }
    xcd_barrier(bar);
    for (int m = gw; m < M; m += NGW) norm_final_row(T + (size_t)m * DM, g_mlp_post, out + (size_t)m * DM, lane);
}

extern "C" void kernel_launch(void* const* d_in, const int* in_sizes, int n_in, void* d_out, int out_size, void* d_ws, size_t ws_size, hipStream_t stream) {
    static int grid = 0;
    if (grid == 0) {
        if (n_in != 16 || in_sizes[0] != M * DM || out_size != M * DM || ws_size < WS_END) { fprintf(stderr, "kernel_launch: unexpected shapes / workspace (n_in %d, in0 %d, out %d, ws %zu); nothing launched\n", n_in, n_in > 0 ? in_sizes[0] : -1, out_size, ws_size); grid = -1; return; }
        int dev = 0, cus = 0, per_cu = 0;
        if (hipGetDevice(&dev) != hipSuccess || hipDeviceGetAttribute(&cus, hipDeviceAttributeMultiprocessorCount, dev) != hipSuccess) { fprintf(stderr, "kernel_launch: device query failed\n"); grid = -1; return; }
        if (hipFuncSetAttribute((const void*)fwd_megakernel, hipFuncAttributeMaxDynamicSharedMemorySize, LDS_BYTES) != hipSuccess) { fprintf(stderr, "kernel_launch: hipFuncSetAttribute failed\n"); grid = -1; return; }
        if (hipOccupancyMaxActiveBlocksPerMultiprocessor(&per_cu, (const void*)fwd_megakernel, NWAVES * 64, LDS_BYTES) != hipSuccess || per_cu < 1) { fprintf(stderr, "kernel_launch: occupancy query reports %d workgroups per CU\n", per_cu); per_cu = per_cu < 1 ? 1 : per_cu; }
        (void)hipGetLastError();
        grid = cus;
    }
    if (grid < 0) return;
    if (hipMemsetAsync((char*)d_ws + WS_CTL, 0, CTL_ZERO_BYTES, stream) != hipSuccess) { fprintf(stderr, "kernel_launch: memset failed\n"); return; }
    Args a{};
    for (int i = 0; i < 16; ++i) a.in[i] = (const float*)d_in[i];
    a.out = (float*)d_out; a.ws = (unsigned char*)d_ws;
    hipLaunchKernelGGL(fwd_megakernel, dim3(grid), dim3(NWAVES * 64), LDS_BYTES, stream, a);
    const hipError_t le = hipPeekAtLastError();
    if (le != hipSuccess) fprintf(stderr, "kernel_launch: launch failed: %s\n", hipGetErrorName(le));
}
```

```cpp
#include <hip/hip_runtime.h>
#include <cstdio>
#include <cstdint>
namespace pg8 {
#define PG8_LAS __attribute__((address_space(3)))
typedef unsigned short bf16_t;
typedef short bf16x8 __attribute__((ext_vector_type(8)));
typedef float f32x4 __attribute__((ext_vector_type(4)));
typedef unsigned u32x4 __attribute__((ext_vector_type(4)));
constexpr int BM = 256, BK = 64, HALF = 128, HTB = HALF * BK * 2  , STAGE_BYTES = 8 * HTB, NXCD = 8, WGM = 8;

__host__ __device__ __forceinline__ int lds_byte(int r, int c) { const int st = (r >> 4) * 2 + (c >> 5), rr = r & 15, cc = c & 31, ob = rr * 64 + cc * 2; return st * 1024 + (ob ^ (((ob >> 9) & 1) << 5)); }
__host__ __device__ __forceinline__ void stage_rc(int b, int& R, int& C) { const int st = b / 1024, sb = b % 1024, swz = sb ^ (((sb >> 9) & 1) << 5); R = (st >> 1) * 16 + swz / 64; C = (st & 1) * 32 + (swz % 64) / 2; }
__host__ __device__ __forceinline__ int perm32(int rho) { const int n = rho >> 4, i = rho & 15; return 8 * (i >> 2) + 4 * n + (i & 3); }

struct Unit { int pm, pn; };
struct Gemm { const bf16_t* A; const bf16_t* Bt; int M, N, K; };

struct StaticOrder {
    int nM, nN, nwg, G, c;
    __host__ __device__ void init(int M, int N, int G_, int c_) { nM = M / BM; nN = N / BM; nwg = nM * nN; G = G_; c = c_; }
    __host__ __device__ bool next(int i, Unit& u) const {
        const long L = (long)i * G + c; if (L >= nwg) return false;
        int wgid = (int)L; { const int q = nwg / NXCD, r = nwg % NXCD, xcd = wgid % NXCD, off = wgid / NXCD; wgid = (xcd < r ? xcd * (q + 1) : r * (q + 1) + (xcd - r) * q) + off; }
        const int nig = WGM * nN, gid = wgid / nig, fm = gid * WGM, gsz = (nM - fm) < WGM ? (nM - fm) : WGM;
        u.pm = fm + ((wgid % nig) % gsz); u.pn = (wgid % nig) / gsz; return true;
    }
    __device__ __forceinline__ void a_ready(const Unit&) const {}
    __device__ __forceinline__ void done(const Unit&) const {}
};


__device__ __forceinline__ unsigned cvt_pk_bf16(float lo, float hi) { unsigned r; asm volatile("v_cvt_pk_bf16_f32 %0, %1, %2" : "=v"(r) : "v"(lo), "v"(hi)); return r; }
struct EpiF32 {
    static constexpr bool PERM = false, AFTER_DRAIN = false;
    float* C; int ldc;
    __device__ __forceinline__ void operator()(const f32x4 (&acc)[2][2][4][2], const Unit& u, int wr, int wc, int fr, int fq) const {
        const int row0 = u.pm * BM + wr * 64 + fr, col0 = u.pn * BM + wc * 32 + 4 * fq;
#pragma unroll
        for (int ai = 0; ai < 2; ++ai)
#pragma unroll
            for (int m = 0; m < 4; ++m) { float* rowp = C + (size_t)(row0 + ai * HALF + m * 16) * ldc + col0;
#pragma unroll
                for (int bj = 0; bj < 2; ++bj)
#pragma unroll
                    for (int n = 0; n < 2; ++n) *(f32x4*)(rowp + bj * HALF + n * 16) = acc[ai][bj][m][n]; }
    }
};
template <int ACT  > struct EpiBf16 {
    static constexpr bool PERM = true, AFTER_DRAIN = false;
    bf16_t* O; int ldc;
    __device__ __forceinline__ void operator()(const f32x4 (&acc)[2][2][4][2], const Unit& u, int wr, int wc, int fr, int fq) const {
        const int row0 = u.pm * BM + wr * 64 + fr; const int col0 = u.pn * BM + wc * 32 + 8 * fq;
#pragma unroll
        for (int ai = 0; ai < 2; ++ai)
#pragma unroll
            for (int m = 0; m < 4; ++m) { bf16_t* rowp = O + (size_t)(row0 + ai * HALF + m * 16) * ldc + col0;
#pragma unroll
                for (int bj = 0; bj < 2; ++bj) { f32x4 v0 = acc[ai][bj][m][0], v1 = acc[ai][bj][m][1];
                    if (ACT == 1) {
#pragma unroll
                        for (int e = 0; e < 4; ++e) { const float a = fmaxf(v0[e], 0.f), b = fmaxf(v1[e], 0.f); v0[e] = a * a; v1[e] = b * b; } }
                    u32x4 w; w.x = cvt_pk_bf16(v0[0], v0[1]); w.y = cvt_pk_bf16(v0[2], v0[3]); w.z = cvt_pk_bf16(v1[0], v1[1]); w.w = cvt_pk_bf16(v1[2], v1[3]);
                    *(u32x4*)(rowp + bj * HALF) = w; } }
    }
};

template <class Epi, class Sched, bool ALIGN_EPI = false, bool SP2 = false>
__device__ __forceinline__ void gemm_phase(PG8_LAS unsigned char* lds, const Gemm g, const Sched& S, const Epi& E) {
    const int tid = threadIdx.x, wid = __builtin_amdgcn_readfirstlane(tid >> 6), lane = tid & 63, wr = wid >> 2, wc = wid & 3, fr = lane & 15, fq = lane >> 4;
    const int K = g.K, nt = K / BK;
    unsigned voffA[2], voffB[2];
#pragma unroll
    for (int i = 0; i < 2; ++i) { int R, C; stage_rc(tid * 16 + i * 8192, R, C); const int Rb = Epi::PERM ? ((R & ~31) + perm32(R & 31)) : R;
        voffA[i] = (unsigned)(R * K + C) * 2u; voffB[i] = (unsigned)(Rb * K + C) * 2u; }
    const size_t kstep = (size_t)(BK * 2);
    const size_t hstep = (size_t)HALF * K * 2;
    const size_t tstep = 2 * hstep;
    const unsigned ldsw = (unsigned)wid * 1024u;
    const int aoff = lds_byte(wr * 64 + fr, fq * 8), boff = lds_byte(wc * 32 + fr, fq * 8);
#define PG8_SA(b, h) (((b) * 2 + (h)) * HTB)
#define PG8_SB(b, h) ((4 + (b) * 2 + (h)) * HTB)
#define PG8_STAGE(bufoff, gbase, voff) do { _Pragma("unroll") for (int _i = 0; _i < 2; ++_i) \
        __builtin_amdgcn_global_load_lds((const unsigned*)((const char*)(gbase) + (voff)[_i]), (PG8_LAS unsigned*)(lds + (bufoff) + ldsw + _i * 8192), 16, 0, 0); } while (0)
#define PG8_LDA(dst, b, h) do { _Pragma("unroll") for (int m = 0; m < 4; ++m) _Pragma("unroll") for (int k = 0; k < 2; ++k) dst[m][k] = *(const PG8_LAS bf16x8*)(lds + PG8_SA(b, h) + aoff + m * 2048 + k * 1024); } while (0)
#define PG8_LDB(dst, b, h) do { _Pragma("unroll") for (int n = 0; n < 2; ++n) _Pragma("unroll") for (int k = 0; k < 2; ++k) dst[n][k] = *(const PG8_LAS bf16x8*)(lds + PG8_SB(b, h) + boff + n * 2048 + k * 1024); } while (0)
#define PG8_MMA(ai, bj, At, Bt) do { __builtin_amdgcn_s_setprio(1); _Pragma("unroll") for (int m = 0; m < 4; ++m) _Pragma("unroll") for (int n = 0; n < 2; ++n) _Pragma("unroll") for (int k = 0; k < 2; ++k) \
        acc[ai][bj][m][n] = __builtin_amdgcn_mfma_f32_16x16x32_bf16(Bt[n][k], At[m][k], acc[ai][bj][m][n], 0, 0, 0); __builtin_amdgcn_s_setprio(0); } while (0)
#define PG8_WAIT_V(n) asm volatile("s_waitcnt vmcnt(" #n ")" ::: "memory")
#define PG8_WAIT_L(n) asm volatile("s_waitcnt lgkmcnt(" #n ")" ::: "memory")
#define PG8_BAR __builtin_amdgcn_s_barrier()
#define PG8_SCHED __builtin_amdgcn_sched_barrier(0)
    Unit cur, nxt; int ui = 0;
    if (!S.next(0, cur)) return;
    f32x4 acc[2][2][4][2];
#pragma unroll
    for (int a = 0; a < 2; ++a)
#pragma unroll
        for (int b = 0; b < 2; ++b)
#pragma unroll
            for (int m = 0; m < 4; ++m)
#pragma unroll
                for (int n = 0; n < 2; ++n) acc[a][b][m][n] = (f32x4){0.f, 0.f, 0.f, 0.f};
    bf16x8 At[4][2], B0[2][2], B1[2][2];
    const char* cA = (const char*)g.A + (size_t)cur.pm * tstep; const char* cB = (const char*)g.Bt + (size_t)cur.pn * tstep;
    S.a_ready(cur);
    if constexpr (SP2) {
        PG8_STAGE(PG8_SB(0, 0), cB, voffB); PG8_STAGE(PG8_SB(0, 1), cB + hstep, voffB); PG8_STAGE(PG8_SA(0, 0), cA, voffA); PG8_STAGE(PG8_SA(0, 1), cA + hstep, voffA);
        if (wr == 1) PG8_BAR;
        PG8_WAIT_V(2); PG8_BAR;
        PG8_STAGE(PG8_SB(1, 0), cB + kstep, voffB); PG8_STAGE(PG8_SA(1, 0), cA + kstep, voffA); PG8_STAGE(PG8_SB(1, 1), cB + hstep + kstep, voffB);
        PG8_WAIT_V(6); PG8_BAR;
    } else {
        PG8_STAGE(PG8_SB(0, 0), cB, voffB); PG8_STAGE(PG8_SA(0, 0), cA, voffA); PG8_STAGE(PG8_SB(0, 1), cB + hstep, voffB); PG8_STAGE(PG8_SA(0, 1), cA + hstep, voffA);
        if (wr == 1) PG8_BAR;
        PG8_WAIT_V(4); PG8_BAR;
        PG8_STAGE(PG8_SB(1, 0), cB + kstep, voffB); PG8_STAGE(PG8_SA(1, 0), cA + kstep, voffA); PG8_STAGE(PG8_SB(1, 1), cB + hstep + kstep, voffB);
        PG8_WAIT_V(6); PG8_BAR;
    }
    for (;;) {
        const bool has_next = S.next(ui + 1, nxt);
        const char* nA = has_next ? (const char*)g.A + (size_t)nxt.pm * tstep : cA; const char* nB = has_next ? (const char*)g.Bt + (size_t)nxt.pn * tstep : cB;
        for (int t = 0; t < nt; t += 2) {
            const bool last = (t == nt - 2);
            const char* a1 = cA + (size_t)(t + 1) * kstep;
            const char* a2 = last ? nA : cA + (size_t)(t + 2) * kstep; const char* b2 = last ? nB : cB + (size_t)(t + 2) * kstep;
            const char* a3 = a2 + kstep; const char* b3 = b2 + kstep;
            if (last && has_next) S.a_ready(nxt);
            if constexpr (SP2) {
            PG8_LDB(B0, 0, 0); PG8_LDB(B1, 0, 1); PG8_SCHED; PG8_LDA(At, 0, 0); PG8_STAGE(PG8_SA(1, 1), a1 + hstep, voffA);
            PG8_WAIT_V(8); PG8_WAIT_L(0); PG8_BAR; PG8_MMA(0, 0, At, B0); PG8_MMA(0, 1, At, B1); PG8_BAR; PG8_SCHED;
            PG8_LDA(At, 0, 1); PG8_STAGE(PG8_SB(0, 0), b2, voffB); PG8_STAGE(PG8_SB(0, 1), b2 + hstep, voffB); PG8_STAGE(PG8_SA(0, 0), a2, voffA);
            PG8_WAIT_V(8); PG8_WAIT_L(0); PG8_BAR; PG8_MMA(1, 0, At, B0); PG8_MMA(1, 1, At, B1); PG8_BAR; PG8_SCHED;
            PG8_LDB(B0, 1, 0); PG8_LDB(B1, 1, 1); PG8_SCHED; PG8_LDA(At, 1, 0); PG8_STAGE(PG8_SA(0, 1), a2 + hstep, voffA);
            PG8_WAIT_V(8); PG8_WAIT_L(0); PG8_BAR; PG8_MMA(0, 0, At, B0); PG8_MMA(0, 1, At, B1); PG8_BAR; PG8_SCHED;
            PG8_LDA(At, 1, 1); PG8_STAGE(PG8_SB(1, 0), b3, voffB); PG8_STAGE(PG8_SB(1, 1), b3 + hstep, voffB); PG8_STAGE(PG8_SA(1, 0), a3, voffA);
            PG8_WAIT_V(8); PG8_WAIT_L(0); PG8_BAR; PG8_MMA(1, 0, At, B0); PG8_MMA(1, 1, At, B1); PG8_BAR; PG8_SCHED;
            } else {
            PG8_LDB(B0, 0, 0); PG8_SCHED; PG8_LDA(At, 0, 0); PG8_STAGE(PG8_SA(1, 1), a1 + hstep, voffA);
            PG8_WAIT_L(8); PG8_BAR; PG8_WAIT_L(0); PG8_MMA(0, 0, At, B0); PG8_BAR; PG8_SCHED;
            PG8_LDB(B1, 0, 1); PG8_STAGE(PG8_SB(0, 0), b2, voffB);
            PG8_BAR; PG8_WAIT_L(0); PG8_MMA(0, 1, At, B1); PG8_BAR;
            PG8_LDA(At, 0, 1); PG8_STAGE(PG8_SA(0, 0), a2, voffA);
            PG8_BAR; PG8_WAIT_L(0); PG8_MMA(1, 0, At, B0); PG8_BAR; PG8_SCHED;
            PG8_STAGE(PG8_SB(0, 1), b2 + hstep, voffB);
            PG8_WAIT_V(6); PG8_BAR; PG8_MMA(1, 1, At, B1); PG8_BAR;
            PG8_LDB(B0, 1, 0); PG8_SCHED; PG8_LDA(At, 1, 0); PG8_STAGE(PG8_SA(0, 1), a2 + hstep, voffA);
            PG8_WAIT_L(8); PG8_BAR; PG8_WAIT_L(0); PG8_MMA(0, 0, At, B0); PG8_BAR; PG8_SCHED;
            PG8_LDB(B1, 1, 1); PG8_STAGE(PG8_SB(1, 0), b3, voffB);
            PG8_BAR; PG8_WAIT_L(0); PG8_MMA(0, 1, At, B1); PG8_BAR;
            PG8_LDA(At, 1, 1); PG8_STAGE(PG8_SA(1, 0), a3, voffA);
            PG8_BAR; PG8_WAIT_L(0); PG8_MMA(1, 0, At, B0); PG8_BAR; PG8_SCHED;
            PG8_STAGE(PG8_SB(1, 1), b3 + hstep, voffB);
            PG8_WAIT_V(6); PG8_BAR; PG8_MMA(1, 1, At, B1); PG8_BAR;
            }
        }
        if constexpr (ALIGN_EPI) { if (wr == 0) PG8_BAR; }
        if constexpr (!Epi::AFTER_DRAIN) { E(acc, cur, wr, wc, fr, fq); S.done(cur); }
        if (!has_next) break;
#pragma unroll
        for (int a = 0; a < 2; ++a)
#pragma unroll
            for (int b = 0; b < 2; ++b)
#pragma unroll
                for (int m = 0; m < 4; ++m)
#pragma unroll
                    for (int n = 0; n < 2; ++n) acc[a][b][m][n] = (f32x4){0.f, 0.f, 0.f, 0.f};
        cur = nxt; cA = nA; cB = nB; ++ui;
        if constexpr (ALIGN_EPI) { if (wr == 1) PG8_BAR; }
    }
    PG8_WAIT_V(0);
    if constexpr (!ALIGN_EPI) { if (wr == 0) PG8_BAR; }
    PG8_BAR;
    if constexpr (Epi::AFTER_DRAIN) { E.fused(acc, cur, wr, wc, fr, fq, lds, wid, lane); S.done(cur); }
#undef PG8_SA
#undef PG8_SB
#undef PG8_STAGE
#undef PG8_LDA
#undef PG8_LDB
#undef PG8_MMA
#undef PG8_WAIT_V
#undef PG8_WAIT_L
#undef PG8_BAR
#undef PG8_SCHED
}
}
#define GAS __attribute__((address_space(1)))
#define LAS __attribute__((address_space(3)))
typedef unsigned short bf16;
typedef unsigned v4u __attribute__((ext_vector_type(4)));
typedef float f32x4 __attribute__((ext_vector_type(4)));
typedef short bf16x8 __attribute__((ext_vector_type(8)));
typedef GAS unsigned gu32;
typedef GAS unsigned long long gu64;
#define RLX_AGENT __ATOMIC_RELAXED, __HIP_MEMORY_SCOPE_AGENT
#define LDS_WAIT() asm volatile("s_waitcnt lgkmcnt(0)" ::: "memory")
#define VM_WAIT() asm volatile("s_waitcnt vmcnt(0)" ::: "memory")
__device__ __forceinline__ unsigned long long rt() { return __builtin_amdgcn_s_memrealtime(); }
__device__ __forceinline__ unsigned f2bf(float f) { unsigned u = __builtin_bit_cast(unsigned, f); return (u + 0x7fffu + ((u >> 16) & 1u)) >> 16; }
__device__ __forceinline__ unsigned pk2(float lo, float hi) { return f2bf(lo) | (f2bf(hi) << 16); }

#define XB_TMO      128
#define XB_XCNT(j)  (256  + 64 * (j))
#define XB_XSUB(j)  (1280 + 64 * (j))
#define XB_XGEN(j)  (2304 + 64 * (j))
#define XB_TOP      3328
#define XB_TOPGEN   3392
#define XCD_BAR_WORDS 3456
#define XB_SPIN_CAP (1u << 18)

__device__ __forceinline__ unsigned xb_ld(unsigned* p)              { return __hip_atomic_load(p, __ATOMIC_RELAXED, __HIP_MEMORY_SCOPE_AGENT); }
__device__ __forceinline__ unsigned xb_add(unsigned* p, unsigned v) { return __hip_atomic_fetch_add(p, v, __ATOMIC_RELAXED, __HIP_MEMORY_SCOPE_AGENT); }
__device__ __forceinline__ unsigned xb_xcc_id() { return (unsigned)__builtin_amdgcn_s_getreg((3 << 11) | 20) & 0xFu; }
#define XB_SPIN(cond, bar) do { unsigned _sp = 0; while (cond) { __builtin_amdgcn_s_sleep(1); \
    if ((++_sp & 255u) == 0u) { if (xb_ld(&(bar)[XB_TMO])) break; if (_sp > XB_SPIN_CAP) { atomicAdd(&(bar)[XB_TMO], 1u); break; } } } } while (0)

struct XcdBarrier {
    unsigned* bar; unsigned x;
    volatile LAS unsigned* st;
};

__device__ __forceinline__ XcdBarrier xcd_barrier_post(unsigned* bar, volatile LAS unsigned* st) {
    XcdBarrier b; b.bar = bar; b.x = xb_xcc_id(); b.st = st;
    if (threadIdx.x == 0) (void)xb_add(&bar[XB_XCNT(b.x)], 1u);
    return b;
}
__device__ __forceinline__ void xcd_barrier_complete(unsigned* bar, unsigned x, unsigned& nloc, unsigned& nx) {
    const unsigned G = gridDim.x * gridDim.y * gridDim.z;
    unsigned sum, cnt, mine, sp = 0u;
    for (;;) {
        sum = 0u; cnt = 0u; mine = 0u;
#pragma unroll
        for (unsigned j = 0; j < 16; ++j) { const unsigned c = xb_ld(&bar[XB_XCNT(j)]); sum += c; cnt += (c > 0u) ? 1u : 0u; mine = (j == x) ? c : mine; }
        if (sum == G) break;
        __builtin_amdgcn_s_sleep(1);
        if ((++sp & 255u) == 0u) { if (xb_ld(&bar[XB_TMO])) break; if (sp > XB_SPIN_CAP) { atomicAdd(&bar[XB_TMO], 1u); break; } }
    }
    nloc = mine > 0u ? mine : 1u; nx = cnt > 0u ? cnt : 1u;
}

__device__ __forceinline__ void xcd_barrier(const XcdBarrier& b) {
    asm volatile("s_waitcnt vmcnt(0)" ::: "memory");
    __syncthreads();
    if (threadIdx.x == 0) {
        unsigned* bar = b.bar;
        __builtin_amdgcn_s_waitcnt(0);
        unsigned nloc = b.st[0], nx = b.st[1];
        if (nloc == 0u) { xcd_barrier_complete(bar, b.x, nloc, nx); b.st[0] = nloc; b.st[1] = nx; }
        const unsigned old = xb_add(&bar[XB_XSUB(b.x)], 1u);
        const unsigned gen = old / nloc;
        if (old + 1u == (gen + 1u) * nloc) {
            __builtin_amdgcn_fence(__ATOMIC_RELEASE, "agent");
            asm volatile("s_waitcnt vmcnt(0)" ::: "memory");
            const unsigned og = xb_add(&bar[XB_TOP], 1u);
            const unsigned tg = og / nx;
            if (og + 1u == (tg + 1u) * nx) xb_add(&bar[XB_TOPGEN], 1u);
            else XB_SPIN(xb_ld(&bar[XB_TOPGEN]) == tg, bar);
            __builtin_amdgcn_fence(__ATOMIC_ACQUIRE, "agent");
            xb_add(&bar[XB_XGEN(b.x)], 1u);
            asm volatile("s_waitcnt vmcnt(0)" ::: "memory");
        } else {
            XB_SPIN(xb_ld(&bar[XB_XGEN(b.x)]) == gen, bar);
            __builtin_amdgcn_fence(__ATOMIC_ACQUIRE, "agent");
            asm volatile("s_waitcnt vmcnt(0)" ::: "memory");
        }
    }
    __syncthreads();
}
constexpr int NWAVES = 8;
constexpr int DM = 1024, BATCH = 8, SEQ = 4096, M = BATCH * SEQ, FF = 4096, INC = 2336, NP = 2560;
constexpr float EPS = 1e-6f;
constexpr int C_GQ = 0, C_GK = 256, C_GV = 512, C_GG = 1024, C_Z = 1536, C_SQ = 1568, C_SK = 2080, C_SV = 2208;
constexpr int P_GQ = 0, P_GK = 64, P_GV = 128, P_GG = 256, P_GH = 384, P_SQ = 1536, P_SK = 2048, P_SV = 2176, P_Z = 2304;
__host__ __device__ constexpr int src_col32(int jb) {
    return jb < 48 ? ((jb % 12) < 2 ? C_GQ + 64 * (jb / 12) + 32 * (jb % 12)
                    : (jb % 12) < 4 ? C_GK + 64 * (jb / 12) + 32 * ((jb % 12) - 2)
                    : (jb % 12) < 8 ? C_GV + 128 * (jb / 12) + 32 * ((jb % 12) - 4)
                                    : C_GG + 128 * (jb / 12) + 32 * ((jb % 12) - 8))
         : jb < 64 ? C_SQ + 32 * (jb - 48) : jb < 68 ? C_SK + 32 * (jb - 64) : jb < 72 ? C_SV + 32 * (jb - 68) : jb == 72 ? C_Z : -1;
}
constexpr size_t MiB = 1u << 20;
constexpr size_t WS_CTL = 0, CTL_ZERO_BYTES = 64 * 1024;
constexpr size_t WS_WIN = 2 * MiB, WS_WO = 8 * MiB, WS_WUP = 10 * MiB, WS_WDN = 18 * MiB;
constexpr size_t WS_U = 32 * MiB;
constexpr size_t WS_PROJ = 96 * MiB;
constexpr size_t WS_MIX = 256 * MiB;
constexpr size_t WS_H = 96 * MiB;
constexpr size_t WS_T = 352 * MiB;
constexpr size_t WS_END = 512 * MiB;
constexpr int CW_BAR = 1024;

constexpr int RING_OFF = 0, RING_BYTES = 131072;
constexpr int LDSCTL_OFF = RING_BYTES, MISC_OFF = LDSCTL_OFF + 320;
constexpr int LDS_BYTES = 147456;

__device__ __forceinline__ float bf2f(unsigned short v) { return __uint_as_float((unsigned)v << 16); }
__device__ __forceinline__ float wave_sum(float v) {
#pragma unroll
    for (int o = 1; o < 64; o <<= 1) v += __shfl_xor(v, o);
    return v;
}
__device__ __forceinline__ void transpose_item(const float* W, int ldw, int K, int src_n0, bf16* WT, int dst_row0, int k0, LAS float* scr, int lane) {
    if (src_n0 >= 0) {
#pragma unroll 8
        for (int i = 0; i < 32; ++i) { const int kk = 2 * i + (lane >> 5); scr[kk * 33 + (lane & 31)] = W[(size_t)(k0 + kk) * ldw + src_n0 + (lane & 31)]; }
    } else {
#pragma unroll 8
        for (int i = 0; i < 32; ++i) { const int kk = 2 * i + (lane >> 5); scr[kk * 33 + (lane & 31)] = 0.f; }
    }
    LDS_WAIT(); asm volatile("" ::: "memory");
    const int c = lane & 7;
#pragma unroll
    for (int j = 0; j < 4; ++j) { const int n = (lane >> 3) + 8 * j; const LAS float* s = scr + (8 * c) * 33 + n;
        v4u o; o.x = pk2(s[0 * 33], s[1 * 33]); o.y = pk2(s[2 * 33], s[3 * 33]); o.z = pk2(s[4 * 33], s[5 * 33]); o.w = pk2(s[6 * 33], s[7 * 33]);
        *(GAS v4u*)(WT + (size_t)(dst_row0 + n) * K + k0 + 8 * c) = o; }
    LDS_WAIT(); asm volatile("" ::: "memory");
}
__device__ __forceinline__ void rms_row_to_bf16(const float* xrow, const float* g, bf16* orow, int lane) {
    const GAS f32x4* xr = (const GAS f32x4*)xrow + lane;
    f32x4 v[4]; float s = 0.f;
#pragma unroll
    for (int j = 0; j < 4; ++j) { v[j] = xr[64 * j]; s += (v[j].x * v[j].x + v[j].y * v[j].y) + (v[j].z * v[j].z + v[j].w * v[j].w); }
    const float rs = 1.f / sqrtf(wave_sum(s) * (1.f / DM) + EPS);
    GAS unsigned long long* o8 = (GAS unsigned long long*)orow + lane;
#pragma unroll
    for (int j = 0; j < 4; ++j) { const f32x4 gg = ((const GAS f32x4*)g)[lane + 64 * j];
        o8[64 * j] = (unsigned long long)pk2(v[j].x * rs * gg.x, v[j].y * rs * gg.y) | ((unsigned long long)pk2(v[j].z * rs * gg.z, v[j].w * rs * gg.w) << 32); }
}
__device__ __forceinline__ float log_sigmoid(float x) { return fminf(x, 0.f) - log1pf(expf(-fabsf(x))); }
__device__ __forceinline__ int t5_bucket(int rel) {
    const int n = rel < 0 ? -rel : rel;
    const int large = 8 + (n >= 12) + (n >= 16) + (n >= 23) + (n >= 32) + (n >= 46) + (n >= 64) + (n >= 91);
    return (rel > 0 ? 16 : 0) + (n < 8 ? n : large);
}

namespace swa {
typedef float f32x16 __attribute__((ext_vector_type(16)));
typedef unsigned u32x2 __attribute__((ext_vector_type(2)));
using pg8::u32x4;
constexpr int KP = 144;
constexpr int VP = 776;
constexpr int OFF_K = 0, OFF_VT = 384 * KP, OFF_BIAS = OFF_VT + 64 * VP, BIAS_P = 260, LDS_NEED = OFF_BIAS + 4 * BIAS_P * 4;
constexpr float LOG2E = 1.4426950408889634f, C2 = 0.125f * LOG2E;
static_assert(LDS_NEED <= RING_BYTES, "swa LDS");
__device__ __forceinline__ int crow(int r, int hh) { return (r & 3) + 8 * (r >> 2) + 4 * hh; }

__device__ __forceinline__ void swa_unit(LAS unsigned char* L, int b, int kvh, int qblk, const bf16* PROJ, const float* sink, const float* relb, bf16* MIX, int tid, int lane, int wave) {
    const int kb0 = qblk - 1, hh = lane >> 5, l31 = lane & 31;
    const size_t rowbase = (size_t)b * SEQ;
#pragma unroll
    for (int it = 0; it < 6; ++it) {
        const int c = it * 512 + tid, kv = c >> 3, dch = c & 7, kabs = kb0 + (kv >> 7);
        if (kabs >= 0 && kabs < SEQ / 128) {
            const v4u val = *(const GAS v4u*)(PROJ + (rowbase + (size_t)(kb0 * 128 + kv)) * NP + P_SK + kvh * 64 + dch * 8);
            *(LAS v4u*)(L + OFF_K + kv * KP + dch * 16) = val;
        }
    }
#pragma unroll
    for (int it = 0; it < 6; ++it) {
        const int c = it * 512 + tid, dch = c / 384, kv = c % 384, kabs = kb0 + (kv >> 7);
        if (kabs >= 0 && kabs < SEQ / 128) {
            const v4u val = *(const GAS v4u*)(PROJ + (rowbase + (size_t)(kb0 * 128 + kv)) * NP + P_SV + kvh * 64 + dch * 8);
            LAS unsigned short* dst = (LAS unsigned short*)(L + OFF_VT + (dch * 8) * VP + kv * 2);
#pragma unroll
            for (int i = 0; i < 4; ++i) { const unsigned w = val[i]; dst[(2 * i) * (VP / 2)] = (unsigned short)(w & 0xffffu); dst[(2 * i + 1) * (VP / 2)] = (unsigned short)(w >> 16); }
        }
    }
    for (int i = tid; i < 4 * 257; i += NWAVES * 64) { const int g = i / 257, r = i % 257;
        ((LAS float*)(L + OFF_BIAS))[g * BIAS_P + r] = relb[t5_bucket(r - 128) * 8 + kvh * 4 + g] * LOG2E; }
    __syncthreads();
    const int g = wave >> 1, qh = kvh * 4 + g;
    const LAS float* biasT = (const LAS float*)(L + OFF_BIAS) + g * BIAS_P;
    const float sink2 = sink[qh] * LOG2E;
    for (int qq = 0; qq < 2; ++qq) {
        const int qb = (wave & 1) * 2 + qq, q_local = 32 * qb + l31;
        const size_t qrow = rowbase + (size_t)qblk * 128 + q_local;
        pg8::bf16x8 qf[4];
#pragma unroll
        for (int ks = 0; ks < 4; ++ks) qf[ks] = *(const GAS pg8::bf16x8*)(PROJ + qrow * NP + P_SQ + qh * 64 + 16 * ks + 8 * hh);
        float m = sink2, l = hh == 0 ? 1.f : 0.f;
        f32x16 o0, o1;
#pragma unroll
        for (int r = 0; r < 16; ++r) { o0[r] = 0.f; o1[r] = 0.f; }
        for (int kbl = 0; kbl < 3; ++kbl) {
            const int kabs = kb0 + kbl;
            if (kabs < 0 || kabs >= SEQ / 128) continue;
            f32x16 s[4];
#pragma unroll
            for (int t = 0; t < 4; ++t) {
#pragma unroll
                for (int r = 0; r < 16; ++r) s[t][r] = 0.f;
#pragma unroll
                for (int ks = 0; ks < 4; ++ks) {
                    const pg8::bf16x8 a = *(const LAS pg8::bf16x8*)(L + OFF_K + (kbl * 128 + t * 32 + l31) * KP + (16 * ks + 8 * hh) * 2);
                    s[t] = __builtin_amdgcn_mfma_f32_32x32x16_bf16(a, qf[ks], s[t], 0, 0, 0);
                }
            }
            const int relbase = (kbl - 1) * 128 - q_local;
            float mx = -1e30f;
#pragma unroll
            for (int t = 0; t < 4; ++t)
#pragma unroll
                for (int r = 0; r < 16; ++r) {
                    const int rel = relbase + t * 32 + crow(r, hh);
                    const bool valid = rel >= -128 && rel <= 128;
                    const int idx = min(max(rel + 128, 0), 256);
                    float v = fmaf(s[t][r], C2, biasT[idx]);
                    v = valid ? v : -1e30f; s[t][r] = v; mx = fmaxf(mx, v);
                }
            mx = fmaxf(mx, __shfl_xor(mx, 32));
            const float mn = fmaxf(m, mx), alpha = __builtin_amdgcn_exp2f(m - mn); m = mn;
            l *= alpha;
#pragma unroll
            for (int r = 0; r < 16; ++r) { o0[r] *= alpha; o1[r] *= alpha; }
#pragma unroll
            for (int t = 0; t < 4; ++t)
#pragma unroll
                for (int r = 0; r < 16; ++r) { const float p = __builtin_amdgcn_exp2f(s[t][r] - m); l += p; s[t][r] = p; }
#pragma unroll
            for (int t = 0; t < 4; ++t)
#pragma unroll
                for (int ss = 0; ss < 2; ++ss) {
                    u32x4 pw; pw.x = pg8::cvt_pk_bf16(s[t][8 * ss + 0], s[t][8 * ss + 1]); pw.y = pg8::cvt_pk_bf16(s[t][8 * ss + 2], s[t][8 * ss + 3]);
                    pw.z = pg8::cvt_pk_bf16(s[t][8 * ss + 4], s[t][8 * ss + 5]); pw.w = pg8::cvt_pk_bf16(s[t][8 * ss + 6], s[t][8 * ss + 7]);
                    const pg8::bf16x8 pb = __builtin_bit_cast(pg8::bf16x8, pw);
                    const int kvb = kbl * 128 + t * 32 + 16 * ss;
#pragma unroll
                    for (int dt = 0; dt < 2; ++dt) {
                        const LAS unsigned char* vp = L + OFF_VT + (dt * 32 + l31) * VP + (kvb + 4 * hh) * 2;
                        const u32x2 lo = *(const LAS u32x2*)vp, hi = *(const LAS u32x2*)(vp + 16);
                        u32x4 aw; aw.x = lo.x; aw.y = lo.y; aw.z = hi.x; aw.w = hi.y;
                        const pg8::bf16x8 va = __builtin_bit_cast(pg8::bf16x8, aw);
                        if (dt == 0) o0 = __builtin_amdgcn_mfma_f32_32x32x16_bf16(va, pb, o0, 0, 0, 0);
                        else         o1 = __builtin_amdgcn_mfma_f32_32x32x16_bf16(va, pb, o1, 0, 0, 0);
                    }
                }
        }
        l += __shfl_xor(l, 32);
        const float inv = 1.f / l;
        bf16* orow = MIX + qrow * DM + 512 + qh * 64;
#pragma unroll
        for (int dt = 0; dt < 2; ++dt)
#pragma unroll
            for (int rq = 0; rq < 4; ++rq) {
                const f32x16& o = dt == 0 ? o0 : o1;
                u32x2 w; w.x = pg8::cvt_pk_bf16(o[4 * rq] * inv, o[4 * rq + 1] * inv); w.y = pg8::cvt_pk_bf16(o[4 * rq + 2] * inv, o[4 * rq + 3] * inv);
                *(GAS u32x2*)(orow + dt * 32 + 8 * rq + 4 * hh) = w;
            }
    }
    __syncthreads();
}
}

__device__ __forceinline__ void gla_simple_task(int task, const bf16* proj, const float* wgf, const float* bgf, const float* wgb, const float* bgb, float* of, float* ob, int lane) {
    int id = task; const int es = id & 15; id >>= 4; const int dir = id & 1; id >>= 1; const int h = id & 3; const int b = id >> 2;
    const float* wg = dir ? wgb : wgf; const float* bg = dir ? bgb : bgf; float* o = dir ? ob : of;
    float w[16];
#pragma unroll
    for (int r = 0; r < 16; ++r) w[r] = wg[r * 256 + h * 64 + lane];
    const float bias = bg[h * 64 + lane];
    float S[8];
#pragma unroll
    for (int e = 0; e < 8; ++e) S[e] = 0.f;
    for (int i = 0; i < SEQ; ++i) {
        const int t = dir ? (SEQ - 1 - i) : i;
        const bf16* pr = proj + (size_t)(b * SEQ + t) * NP;
        float pre = bias;
#pragma unroll
        for (int r = 0; r < 16; ++r) pre = fmaf(bf2f(pr[P_Z + dir * 16 + r]), w[r], pre);
        const float a = expf(log_sigmoid(pre) * (1.f / 16.f));
        const float q = bf2f(pr[P_GH * h + P_GQ + lane]) * 0.125f, k = bf2f(pr[P_GH * h + P_GK + lane]);
        float part[8];
#pragma unroll
        for (int e = 0; e < 8; ++e) { const float v = bf2f(pr[P_GH * h + P_GV + es * 8 + e]); S[e] = fmaf(a, S[e], k * v); part[e] = q * S[e]; }
#pragma unroll
        for (int e = 0; e < 8; ++e) part[e] = wave_sum(part[e]);
        if (lane < 8) { float v = part[0];
#pragma unroll
            for (int e = 1; e < 8; ++e) v = (lane == e) ? part[e] : v;
            o[(size_t)(b * SEQ + t) * 512 + h * 128 + es * 8 + lane] = v; }
    }
}
__device__ __forceinline__ void gla_post_task(int w, const float* of, const float* ob, const bf16* proj, const float* gn, bf16* mix, int lane) {
    const int tok = w >> 2, h = w & 3;
    const size_t off = (size_t)tok * 512 + h * 128;
    const float v0 = of[off + lane] + ob[off + lane], v1 = of[off + 64 + lane] + ob[off + 64 + lane];
    const float rs = 1.f / sqrtf(wave_sum(v0 * v0 + v1 * v1) * (1.f / 128.f) + EPS);
    const float g0 = bf2f(proj[(size_t)tok * NP + P_GH * h + P_GG + lane]), g1 = bf2f(proj[(size_t)tok * NP + P_GH * h + P_GG + 64 + lane]);
    mix[(size_t)tok * DM + h * 128 + lane] = (bf16)f2bf(v0 * rs * gn[lane] * (g0 / (1.f + expf(-g0))));
    mix[(size_t)tok * DM + h * 128 + 64 + lane] = (bf16)f2bf(v1 * rs * gn[64 + lane] * (g1 / (1.f + expf(-g1))));
}
__device__ __forceinline__ void swa_simple_task(int w, const bf16* proj, const float* sink, const float* relb, bf16* mix, LAS float* scr, int lane) {
    const int tok = w >> 3, qh = w & 7, kvh = qh >> 2, b = tok / SEQ, i = tok % SEQ;
    LAS float* qs = scr; LAS float* ps = scr + 64;
    qs[lane] = bf2f(proj[(size_t)tok * NP + P_SQ + qh * 64 + lane]);
    LDS_WAIT(); asm volatile("" ::: "memory");
    float lg[5]; float mx = sink[qh];
#pragma unroll
    for (int c = 0; c < 5; ++c) {
        const int jj = c * 64 + lane, j = i - 128 + jj;
        float l = -1e30f;
        if (jj <= 256 && j >= 0 && j < SEQ) {
            const bf16* kr = proj + (size_t)(b * SEQ + j) * NP + P_SK + kvh * 64;
            float dot = 0.f;
            for (int d = 0; d < 64; ++d) dot = fmaf(qs[d], bf2f(kr[d]), dot);
            l = dot * 0.125f + relb[t5_bucket(j - i) * 8 + qh];
        }
        lg[c] = l; mx = fmaxf(mx, l);
    }
#pragma unroll
    for (int o = 1; o < 64; o <<= 1) mx = fmaxf(mx, __shfl_xor(mx, o));
    float den = 0.f;
#pragma unroll
    for (int c = 0; c < 5; ++c) { const float p = (lg[c] > -1e29f) ? expf(lg[c] - mx) : 0.f; ps[c * 64 + lane] = p; den += p; }
    den = wave_sum(den) + expf(sink[qh] - mx);
    LDS_WAIT(); asm volatile("" ::: "memory");
    float acc = 0.f;
    for (int jj = 0; jj <= 256; ++jj) {
        const int j = i - 128 + jj;
        if (j < 0 || j >= SEQ) continue;
        acc = fmaf(ps[jj], bf2f(proj[(size_t)(b * SEQ + j) * NP + P_SV + kvh * 64 + lane]), acc);
    }
    mix[(size_t)tok * DM + 512 + qh * 64 + lane] = (bf16)f2bf(acc / den);
    LDS_WAIT(); asm volatile("" ::: "memory");
}
__device__ __forceinline__ void norm_mid_row(const float* trow, const float* xrow, const float* g1, const float* g2, float* orow, bf16* xnrow, int lane) {
    f32x4 t[4], h[4]; float s = 0.f;
#pragma unroll
    for (int j = 0; j < 4; ++j) { t[j] = ((const GAS f32x4*)trow)[lane + 64 * j]; s += (t[j].x * t[j].x + t[j].y * t[j].y) + (t[j].z * t[j].z + t[j].w * t[j].w); }
    const float rs = 1.f / sqrtf(wave_sum(s) * (1.f / DM) + EPS); float s2 = 0.f;
#pragma unroll
    for (int j = 0; j < 4; ++j) { const f32x4 gg = ((const GAS f32x4*)g1)[lane + 64 * j], xx = ((const GAS f32x4*)xrow)[lane + 64 * j];
        h[j] = xx + t[j] * rs * gg; ((GAS f32x4*)orow)[lane + 64 * j] = h[j]; s2 += (h[j].x * h[j].x + h[j].y * h[j].y) + (h[j].z * h[j].z + h[j].w * h[j].w); }
    const float rs2 = 1.f / sqrtf(wave_sum(s2) * (1.f / DM) + EPS);
    GAS unsigned long long* o8 = (GAS unsigned long long*)xnrow + lane;
#pragma unroll
    for (int j = 0; j < 4; ++j) { const f32x4 gg = ((const GAS f32x4*)g2)[lane + 64 * j];
        o8[64 * j] = (unsigned long long)pk2(h[j].x * rs2 * gg.x, h[j].y * rs2 * gg.y) | ((unsigned long long)pk2(h[j].z * rs2 * gg.z, h[j].w * rs2 * gg.w) << 32); }
}
__device__ __forceinline__ void norm_final_row(const float* trow, const float* g, float* orow, int lane) {
    f32x4 t[4]; float s = 0.f;
#pragma unroll
    for (int j = 0; j < 4; ++j) { t[j] = ((const GAS f32x4*)trow)[lane + 64 * j]; s += (t[j].x * t[j].x + t[j].y * t[j].y) + (t[j].z * t[j].z + t[j].w * t[j].w); }
    const float rs = 1.f / sqrtf(wave_sum(s) * (1.f / DM) + EPS);
#pragma unroll
    for (int j = 0; j < 4; ++j) { const f32x4 gg = ((const GAS f32x4*)g)[lane + 64 * j]; GAS f32x4* op = (GAS f32x4*)orow + lane + 64 * j; *op = *op + t[j] * rs * gg; }
}

struct Args { const float* in[16]; float* out; unsigned char* ws; };
__global__ void __launch_bounds__(NWAVES * 64, 2) fwd_megakernel(Args args) {
    extern __shared__ __attribute__((aligned(16))) unsigned char lds[];
    LAS unsigned char* L = (LAS unsigned char*)lds;
    volatile LAS unsigned* MISC = (volatile LAS unsigned*)(L + MISC_OFF);
    const int tid = threadIdx.x, lane = tid & 63, wave = __builtin_amdgcn_readfirstlane(tid >> 6);
    const int G = gridDim.x; const int bx = blockIdx.x; const int vcu = (G % 8 == 0) ? (bx % 8) * (G / 8) + bx / 8 : bx;
    const int gw = vcu * NWAVES + wave, NGW = G * NWAVES;
    unsigned char* ws = args.ws;
    gu32* ctl = (gu32*)(ws + WS_CTL);
    const float* x = args.in[0]; const float* g_pre = args.in[1]; const float* w_in = args.in[2];
    const float* wgf = args.in[3]; const float* bgf = args.in[4]; const float* wgb = args.in[5]; const float* bgb = args.in[6];
    const float* gla_norm = args.in[7]; const float* sink = args.in[8]; const float* relb = args.in[9];
    const float* w_out = args.in[10]; const float* g_post = args.in[11]; const float* g_mlp_pre = args.in[12];
    const float* w_up = args.in[13]; const float* w_down = args.in[14]; const float* g_mlp_post = args.in[15];
    float* out = args.out;
    bf16* Win_t = (bf16*)(ws + WS_WIN); bf16* Wo_t = (bf16*)(ws + WS_WO); bf16* Wup_t = (bf16*)(ws + WS_WUP); bf16* Wdn_t = (bf16*)(ws + WS_WDN);
    bf16* U = (bf16*)(ws + WS_U); bf16* PROJ = (bf16*)(ws + WS_PROJ); bf16* MIX = (bf16*)(ws + WS_MIX); bf16* HB = (bf16*)(ws + WS_H);
    float* T = (float*)(ws + WS_T); float* OF = T; float* OB = T + (size_t)M * 512;

    for (int u = tid; u < (LDS_BYTES - LDSCTL_OFF) / 4; u += NWAVES * 64) ((LAS unsigned*)(L + LDSCTL_OFF))[u] = 0u;
    __syncthreads();
    XcdBarrier bar = xcd_barrier_post((unsigned*)(ctl + CW_BAR), MISC + 8);

    {
        LAS float* scr = (LAS float*)(L + RING_OFF + wave * 16384);
        constexpr int I_IN = 16 * (NP / 32), I_O = 16 * 32, I_UP = 16 * 128, I_DN = 64 * 32, NITEMS = I_IN + I_O + I_UP + I_DN;
        for (int it = gw; it < NITEMS; it += NGW) {
            int r = it;
            if (r < I_IN) { const int kb = r / (NP / 32), jb = r % (NP / 32); transpose_item(w_in, INC, DM, src_col32(jb), Win_t, 32 * jb, 64 * kb, scr, lane); continue; } r -= I_IN;
            if (r < I_O) { const int kb = r / 32, jb = r % 32; transpose_item(w_out, DM, DM, 32 * jb, Wo_t, 32 * jb, 64 * kb, scr, lane); continue; } r -= I_O;
            if (r < I_UP) { const int kb = r / 128, jb = r % 128; transpose_item(w_up, FF, DM, 32 * jb, Wup_t, 32 * jb, 64 * kb, scr, lane); continue; } r -= I_UP;
            { const int kb = r / 32, jb = r % 32; transpose_item(w_down, DM, FF, 32 * jb, Wdn_t, 32 * jb, 64 * kb, scr, lane); }
        }
        for (int m = gw; m < M; m += NGW) rms_row_to_bf16(x + (size_t)m * DM, g_pre, U + (size_t)m * DM, lane);
    }
    xcd_barrier(bar);

    {
        pg8::Gemm g{U, Win_t, M, NP, DM}; pg8::StaticOrder S; S.init(M, NP, G, bx);
        pg8::EpiBf16<0> E{PROJ, NP};
        pg8::gemm_phase<pg8::EpiBf16<0>, pg8::StaticOrder, true, true>(L + RING_OFF, g, S, E);
    }
    xcd_barrier(bar);

    if ((gw & 1) == 0) gla_simple_task(gw >> 1, PROJ, wgf, bgf, wgb, bgb, OF, OB, lane);
    xcd_barrier(bar);
    for (int w = gw; w < M * 4; w += NGW) gla_post_task(w, OF, OB, PROJ, gla_norm, MIX, lane);
    for (int id = vcu; id < BATCH * 2 * (SEQ / 128); id += G) swa::swa_unit(L + RING_OFF, id >> 6, (id >> 5) & 1, id & 31, PROJ, sink, relb, MIX, tid, lane, wave);
    xcd_barrier(bar);

    {
        pg8::Gemm g{MIX, Wo_t, M, DM, DM}; pg8::StaticOrder S; S.init(M, DM, G, bx);
        pg8::EpiF32 E{T, DM};
        pg8::gemm_phase<pg8::EpiF32, pg8::StaticOrder, true, true>(L + RING_OFF, g, S, E);
    }
    xcd_barrier(bar);
    for (int m = gw; m < M; m += NGW) norm_mid_row(T + (size_t)m * DM, x + (size_t)m * DM, g_post, g_mlp_pre, out + (size_t)m * DM, U + (size_t)m * DM, lane);
    xcd_barrier(bar);

    {
        pg8::Gemm g{U, Wup_t, M, FF, DM}; pg8::StaticOrder S; S.init(M, FF, G, bx);
        pg8::EpiBf16<1> E{HB, FF};
        pg8::gemm_phase<pg8::EpiBf16<1>, pg8::StaticOrder, true, true>(L + RING_OFF, g, S, E);
    }
    xcd_barrier(bar);

    {
        pg8::Gemm g{HB, Wdn_t, M, DM, FF}; pg8::StaticOrder S; S.init(M, DM, G, bx);
        pg8::EpiF32 E{T, DM};
        pg8::gemm_phase<pg8::EpiF32, pg8::StaticOrder, true, true>(L + RING_OFF, g, S, E);
    }
    xcd_barrier(bar);
    for (int m = gw; m < M; m += NGW) norm_final_row(T + (size_t)m * DM, g_mlp_post, out + (size_t)m * DM, lane);
}

extern "C" void kernel_launch(void* const* d_in, const int* in_sizes, int n_in, void* d_out, int out_size, void* d_ws, size_t ws_size, hipStream_t stream) {
    static int grid = 0;
    if (grid == 0) {
        if (n_in != 16 || in_sizes[0] != M * DM || out_size != M * DM || ws_size < WS_END) { fprintf(stderr, "kernel_launch: unexpected shapes / workspace (n_in %d, in0 %d, out %d, ws %zu); nothing launched\n", n_in, n_in > 0 ? in_sizes[0] : -1, out_size, ws_size); grid = -1; return; }
        int dev = 0, cus = 0, per_cu = 0;
        if (hipGetDevice(&dev) != hipSuccess || hipDeviceGetAttribute(&cus, hipDeviceAttributeMultiprocessorCount, dev) != hipSuccess) { fprintf(stderr, "kernel_launch: device query failed\n"); grid = -1; return; }
        if (hipFuncSetAttribute((const void*)fwd_megakernel, hipFuncAttributeMaxDynamicSharedMemorySize, LDS_BYTES) != hipSuccess) { fprintf(stderr, "kernel_launch: hipFuncSetAttribute failed\n"); grid = -1; return; }
        if (hipOccupancyMaxActiveBlocksPerMultiprocessor(&per_cu, (const void*)fwd_megakernel, NWAVES * 64, LDS_BYTES) != hipSuccess || per_cu < 1) { fprintf(stderr, "kernel_launch: occupancy query reports %d workgroups per CU\n", per_cu); per_cu = per_cu < 1 ? 1 : per_cu; }
        (void)hipGetLastError();
        grid = cus;
    }
    if (grid < 0) return;
    if (hipMemsetAsync((char*)d_ws + WS_CTL, 0, CTL_ZERO_BYTES, stream) != hipSuccess) { fprintf(stderr, "kernel_launch: memset failed\n"); return; }
    Args a{};
    for (int i = 0; i < 16; ++i) a.in[i] = (const float*)d_in[i];
    a.out = (float*)d_out; a.ws = (unsigned char*)d_ws;
    hipLaunchKernelGGL(fwd_megakernel, dim3(grid), dim3(NWAVES * 64), LDS_BYTES, stream, a);
    const hipError_t le = hipPeekAtLastError();
    if (le != hipSuccess) fprintf(stderr, "kernel_launch: launch failed: %s\n", hipGetErrorName(le));
}
```

```cpp
#include <hip/hip_runtime.h>
#include <cstdio>
#include <cstdint>
namespace pg8 {
#define PG8_LAS __attribute__((address_space(3)))
typedef unsigned short bf16_t;
typedef short bf16x8 __attribute__((ext_vector_type(8)));
typedef float f32x4 __attribute__((ext_vector_type(4)));
typedef unsigned u32x4 __attribute__((ext_vector_type(4)));
constexpr int BM = 256, BK = 64, HALF = 128, HTB = HALF * BK * 2  , STAGE_BYTES = 8 * HTB, NXCD = 8, WGM = 8;

__host__ __device__ __forceinline__ int lds_byte(int r, int c) { const int st = (r >> 4) * 2 + (c >> 5), rr = r & 15, cc = c & 31, ob = rr * 64 + cc * 2; return st * 1024 + (ob ^ (((ob >> 9) & 1) << 5)); }
__host__ __device__ __forceinline__ void stage_rc(int b, int& R, int& C) { const int st = b / 1024, sb = b % 1024, swz = sb ^ (((sb >> 9) & 1) << 5); R = (st >> 1) * 16 + swz / 64; C = (st & 1) * 32 + (swz % 64) / 2; }
__host__ __device__ __forceinline__ int perm32(int rho) { const int n = rho >> 4, i = rho & 15; return 8 * (i >> 2) + 4 * n + (i & 3); }

struct Unit { int pm, pn; };
struct Gemm { const bf16_t* A; const bf16_t* Bt; int M, N, K; };

struct StaticOrder {
    int nM, nN, nwg, G, c;
    __host__ __device__ void init(int M, int N, int G_, int c_) { nM = M / BM; nN = N / BM; nwg = nM * nN; G = G_; c = c_; }
    __host__ __device__ bool next(int i, Unit& u) const {
        const long L = (long)i * G + c; if (L >= nwg) return false;
        int wgid = (int)L; { const int q = nwg / NXCD, r = nwg % NXCD, xcd = wgid % NXCD, off = wgid / NXCD; wgid = (xcd < r ? xcd * (q + 1) : r * (q + 1) + (xcd - r) * q) + off; }
        const int nig = WGM * nN, gid = wgid / nig, fm = gid * WGM, gsz = (nM - fm) < WGM ? (nM - fm) : WGM;
        u.pm = fm + ((wgid % nig) % gsz); u.pn = (wgid % nig) / gsz; return true;
    }
    __device__ __forceinline__ void a_ready(const Unit&) const {}
    __device__ __forceinline__ void done(const Unit&) const {}
};


__device__ __forceinline__ unsigned cvt_pk_bf16(float lo, float hi) { unsigned r; asm volatile("v_cvt_pk_bf16_f32 %0, %1, %2" : "=v"(r) : "v"(lo), "v"(hi)); return r; }
struct EpiF32 {
    static constexpr bool PERM = false, AFTER_DRAIN = false;
    float* C; int ldc;
    __device__ __forceinline__ void operator()(const f32x4 (&acc)[2][2][4][2], const Unit& u, int wr, int wc, int fr, int fq) const {
        const int row0 = u.pm * BM + wr * 64 + fr, col0 = u.pn * BM + wc * 32 + 4 * fq;
#pragma unroll
        for (int ai = 0; ai < 2; ++ai)
#pragma unroll
            for (int m = 0; m < 4; ++m) { float* rowp = C + (size_t)(row0 + ai * HALF + m * 16) * ldc + col0;
#pragma unroll
                for (int bj = 0; bj < 2; ++bj)
#pragma unroll
                    for (int n = 0; n < 2; ++n) *(f32x4*)(rowp + bj * HALF + n * 16) = acc[ai][bj][m][n]; }
    }
};
template <int ACT  > struct EpiBf16 {
    static constexpr bool PERM = true, AFTER_DRAIN = false;
    bf16_t* O; int ldc;
    __device__ __forceinline__ void operator()(const f32x4 (&acc)[2][2][4][2], const Unit& u, int wr, int wc, int fr, int fq) const {
        const int row0 = u.pm * BM + wr * 64 + fr; const int col0 = u.pn * BM + wc * 32 + 8 * fq;
#pragma unroll
        for (int ai = 0; ai < 2; ++ai)
#pragma unroll
            for (int m = 0; m < 4; ++m) { bf16_t* rowp = O + (size_t)(row0 + ai * HALF + m * 16) * ldc + col0;
#pragma unroll
                for (int bj = 0; bj < 2; ++bj) { f32x4 v0 = acc[ai][bj][m][0], v1 = acc[ai][bj][m][1];
                    if (ACT == 1) {
#pragma unroll
                        for (int e = 0; e < 4; ++e) { const float a = fmaxf(v0[e], 0.f), b = fmaxf(v1[e], 0.f); v0[e] = a * a; v1[e] = b * b; } }
                    u32x4 w; w.x = cvt_pk_bf16(v0[0], v0[1]); w.y = cvt_pk_bf16(v0[2], v0[3]); w.z = cvt_pk_bf16(v1[0], v1[1]); w.w = cvt_pk_bf16(v1[2], v1[3]);
                    *(u32x4*)(rowp + bj * HALF) = w; } }
    }
};

template <class Epi, class Sched, bool ALIGN_EPI = false, bool SP2 = false>
__device__ __forceinline__ void gemm_phase(PG8_LAS unsigned char* lds, const Gemm g, const Sched& S, const Epi& E) {
    const int tid = threadIdx.x, wid = __builtin_amdgcn_readfirstlane(tid >> 6), lane = tid & 63, wr = wid >> 2, wc = wid & 3, fr = lane & 15, fq = lane >> 4;
    const int K = g.K, nt = K / BK;
    unsigned voffA[2], voffB[2];
#pragma unroll
    for (int i = 0; i < 2; ++i) { int R, C; stage_rc(tid * 16 + i * 8192, R, C); const int Rb = Epi::PERM ? ((R & ~31) + perm32(R & 31)) : R;
        voffA[i] = (unsigned)(R * K + C) * 2u; voffB[i] = (unsigned)(Rb * K + C) * 2u; }
    const size_t kstep = (size_t)(BK * 2);
    const size_t hstep = (size_t)HALF * K * 2;
    const size_t tstep = 2 * hstep;
    const unsigned ldsw = (unsigned)wid * 1024u;
    const int aoff = lds_byte(wr * 64 + fr, fq * 8), boff = lds_byte(wc * 32 + fr, fq * 8);
#define PG8_SA(b, h) (((b) * 2 + (h)) * HTB)
#define PG8_SB(b, h) ((4 + (b) * 2 + (h)) * HTB)
#define PG8_STAGE(bufoff, gbase, voff) do { _Pragma("unroll") for (int _i = 0; _i < 2; ++_i) \
        __builtin_amdgcn_global_load_lds((const unsigned*)((const char*)(gbase) + (voff)[_i]), (PG8_LAS unsigned*)(lds + (bufoff) + ldsw + _i * 8192), 16, 0, 0); } while (0)
#define PG8_LDA(dst, b, h) do { _Pragma("unroll") for (int m = 0; m < 4; ++m) _Pragma("unroll") for (int k = 0; k < 2; ++k) dst[m][k] = *(const PG8_LAS bf16x8*)(lds + PG8_SA(b, h) + aoff + m * 2048 + k * 1024); } while (0)
#define PG8_LDB(dst, b, h) do { _Pragma("unroll") for (int n = 0; n < 2; ++n) _Pragma("unroll") for (int k = 0; k < 2; ++k) dst[n][k] = *(const PG8_LAS bf16x8*)(lds + PG8_SB(b, h) + boff + n * 2048 + k * 1024); } while (0)
#define PG8_MMA(ai, bj, At, Bt) do { __builtin_amdgcn_s_setprio(1); _Pragma("unroll") for (int m = 0; m < 4; ++m) _Pragma("unroll") for (int n = 0; n < 2; ++n) _Pragma("unroll") for (int k = 0; k < 2; ++k) \
        acc[ai][bj][m][n] = __builtin_amdgcn_mfma_f32_16x16x32_bf16(Bt[n][k], At[m][k], acc[ai][bj][m][n], 0, 0, 0); __builtin_amdgcn_s_setprio(0); } while (0)
#define PG8_WAIT_V(n) asm volatile("s_waitcnt vmcnt(" #n ")" ::: "memory")
#define PG8_WAIT_L(n) asm volatile("s_waitcnt lgkmcnt(" #n ")" ::: "memory")
#define PG8_BAR __builtin_amdgcn_s_barrier()
#define PG8_SCHED __builtin_amdgcn_sched_barrier(0)
    Unit cur, nxt; int ui = 0;
    if (!S.next(0, cur)) return;
    f32x4 acc[2][2][4][2];
#pragma unroll
    for (int a = 0; a < 2; ++a)
#pragma unroll
        for (int b = 0; b < 2; ++b)
#pragma unroll
            for (int m = 0; m < 4; ++m)
#pragma unroll
                for (int n = 0; n < 2; ++n) acc[a][b][m][n] = (f32x4){0.f, 0.f, 0.f, 0.f};
    bf16x8 At[4][2], B0[2][2], B1[2][2];
    const char* cA = (const char*)g.A + (size_t)cur.pm * tstep; const char* cB = (const char*)g.Bt + (size_t)cur.pn * tstep;
    S.a_ready(cur);
    if constexpr (SP2) {
        PG8_STAGE(PG8_SB(0, 0), cB, voffB); PG8_STAGE(PG8_SB(0, 1), cB + hstep, voffB); PG8_STAGE(PG8_SA(0, 0), cA, voffA); PG8_STAGE(PG8_SA(0, 1), cA + hstep, voffA);
        if (wr == 1) PG8_BAR;
        PG8_WAIT_V(2); PG8_BAR;
        PG8_STAGE(PG8_SB(1, 0), cB + kstep, voffB); PG8_STAGE(PG8_SA(1, 0), cA + kstep, voffA); PG8_STAGE(PG8_SB(1, 1), cB + hstep + kstep, voffB);
        PG8_WAIT_V(6); PG8_BAR;
    } else {
        PG8_STAGE(PG8_SB(0, 0), cB, voffB); PG8_STAGE(PG8_SA(0, 0), cA, voffA); PG8_STAGE(PG8_SB(0, 1), cB + hstep, voffB); PG8_STAGE(PG8_SA(0, 1), cA + hstep, voffA);
        if (wr == 1) PG8_BAR;
        PG8_WAIT_V(4); PG8_BAR;
        PG8_STAGE(PG8_SB(1, 0), cB + kstep, voffB); PG8_STAGE(PG8_SA(1, 0), cA + kstep, voffA); PG8_STAGE(PG8_SB(1, 1), cB + hstep + kstep, voffB);
        PG8_WAIT_V(6); PG8_BAR;
    }
    for (;;) {
        const bool has_next = S.next(ui + 1, nxt);
        const char* nA = has_next ? (const char*)g.A + (size_t)nxt.pm * tstep : cA; const char* nB = has_next ? (const char*)g.Bt + (size_t)nxt.pn * tstep : cB;
        for (int t = 0; t < nt; t += 2) {
            const bool last = (t == nt - 2);
            const char* a1 = cA + (size_t)(t + 1) * kstep;
            const char* a2 = last ? nA : cA + (size_t)(t + 2) * kstep; const char* b2 = last ? nB : cB + (size_t)(t + 2) * kstep;
            const char* a3 = a2 + kstep; const char* b3 = b2 + kstep;
            if (last && has_next) S.a_ready(nxt);
            if constexpr (SP2) {
            PG8_LDB(B0, 0, 0); PG8_LDB(B1, 0, 1); PG8_SCHED; PG8_LDA(At, 0, 0); PG8_STAGE(PG8_SA(1, 1), a1 + hstep, voffA);
            PG8_WAIT_V(8); PG8_WAIT_L(0); PG8_BAR; PG8_MMA(0, 0, At, B0); PG8_MMA(0, 1, At, B1); PG8_BAR; PG8_SCHED;
            PG8_LDA(At, 0, 1); PG8_STAGE(PG8_SB(0, 0), b2, voffB); PG8_STAGE(PG8_SB(0, 1), b2 + hstep, voffB); PG8_STAGE(PG8_SA(0, 0), a2, voffA);
            PG8_WAIT_V(8); PG8_WAIT_L(0); PG8_BAR; PG8_MMA(1, 0, At, B0); PG8_MMA(1, 1, At, B1); PG8_BAR; PG8_SCHED;
            PG8_LDB(B0, 1, 0); PG8_LDB(B1, 1, 1); PG8_SCHED; PG8_LDA(At, 1, 0); PG8_STAGE(PG8_SA(0, 1), a2 + hstep, voffA);
            PG8_WAIT_V(8); PG8_WAIT_L(0); PG8_BAR; PG8_MMA(0, 0, At, B0); PG8_MMA(0, 1, At, B1); PG8_BAR; PG8_SCHED;
            PG8_LDA(At, 1, 1); PG8_STAGE(PG8_SB(1, 0), b3, voffB); PG8_STAGE(PG8_SB(1, 1), b3 + hstep, voffB); PG8_STAGE(PG8_SA(1, 0), a3, voffA);
            PG8_WAIT_V(8); PG8_WAIT_L(0); PG8_BAR; PG8_MMA(1, 0, At, B0); PG8_MMA(1, 1, At, B1); PG8_BAR; PG8_SCHED;
            } else {
            PG8_LDB(B0, 0, 0); PG8_SCHED; PG8_LDA(At, 0, 0); PG8_STAGE(PG8_SA(1, 1), a1 + hstep, voffA);
            PG8_WAIT_L(8); PG8_BAR; PG8_WAIT_L(0); PG8_MMA(0, 0, At, B0); PG8_BAR; PG8_SCHED;
            PG8_LDB(B1, 0, 1); PG8_STAGE(PG8_SB(0, 0), b2, voffB);
            PG8_BAR; PG8_WAIT_L(0); PG8_MMA(0, 1, At, B1); PG8_BAR;
            PG8_LDA(At, 0, 1); PG8_STAGE(PG8_SA(0, 0), a2, voffA);
            PG8_BAR; PG8_WAIT_L(0); PG8_MMA(1, 0, At, B0); PG8_BAR; PG8_SCHED;
            PG8_STAGE(PG8_SB(0, 1), b2 + hstep, voffB);
            PG8_WAIT_V(6); PG8_BAR; PG8_MMA(1, 1, At, B1); PG8_BAR;
            PG8_LDB(B0, 1, 0); PG8_SCHED; PG8_LDA(At, 1, 0); PG8_STAGE(PG8_SA(0, 1), a2 + hstep, voffA);
            PG8_WAIT_L(8); PG8_BAR; PG8_WAIT_L(0); PG8_MMA(0, 0, At, B0); PG8_BAR; PG8_SCHED;
            PG8_LDB(B1, 1, 1); PG8_STAGE(PG8_SB(1, 0), b3, voffB);
            PG8_BAR; PG8_WAIT_L(0); PG8_MMA(0, 1, At, B1); PG8_BAR;
            PG8_LDA(At, 1, 1); PG8_STAGE(PG8_SA(1, 0), a3, voffA);
            PG8_BAR; PG8_WAIT_L(0); PG8_MMA(1, 0, At, B0); PG8_BAR; PG8_SCHED;
            PG8_STAGE(PG8_SB(1, 1), b3 + hstep, voffB);
            PG8_WAIT_V(6); PG8_BAR; PG8_MMA(1, 1, At, B1); PG8_BAR;
            }
        }
        if constexpr (ALIGN_EPI) { if (wr == 0) PG8_BAR; }
        if constexpr (!Epi::AFTER_DRAIN) { E(acc, cur, wr, wc, fr, fq); S.done(cur); }
        if (!has_next) break;
#pragma unroll
        for (int a = 0; a < 2; ++a)
#pragma unroll
            for (int b = 0; b < 2; ++b)
#pragma unroll
                for (int m = 0; m < 4; ++m)
#pragma unroll
                    for (int n = 0; n < 2; ++n) acc[a][b][m][n] = (f32x4){0.f, 0.f, 0.f, 0.f};
        cur = nxt; cA = nA; cB = nB; ++ui;
        if constexpr (ALIGN_EPI) { if (wr == 1) PG8_BAR; }
    }
    PG8_WAIT_V(0);
    if constexpr (!ALIGN_EPI) { if (wr == 0) PG8_BAR; }
    PG8_BAR;
    if constexpr (Epi::AFTER_DRAIN) { E.fused(acc, cur, wr, wc, fr, fq, lds, wid, lane); S.done(cur); }
#undef PG8_SA
#undef PG8_SB
#undef PG8_STAGE
#undef PG8_LDA
#undef PG8_LDB
#undef PG8_MMA
#undef PG8_WAIT_V
#undef PG8_WAIT_L
#undef PG8_BAR
#undef PG8_SCHED
}
}
#define GAS __attribute__((address_space(1)))
#define LAS __attribute__((address_space(3)))
typedef unsigned short bf16;
typedef unsigned v4u __attribute__((ext_vector_type(4)));
typedef float f32x4 __attribute__((ext_vector_type(4)));
typedef short bf16x8 __attribute__((ext_vector_type(8)));
typedef GAS unsigned gu32;
typedef GAS unsigned long long gu64;
#define RLX_AGENT __ATOMIC_RELAXED, __HIP_MEMORY_SCOPE_AGENT
#define LDS_WAIT() asm volatile("s_waitcnt lgkmcnt(0)" ::: "memory")
#define VM_WAIT() asm volatile("s_waitcnt vmcnt(0)" ::: "memory")
__device__ __forceinline__ unsigned long long rt() { return __builtin_amdgcn_s_memrealtime(); }
__device__ __forceinline__ unsigned f2bf(float f) { unsigned u = __builtin_bit_cast(unsigned, f); return (u + 0x7fffu + ((u >> 16) & 1u)) >> 16; }
__device__ __forceinline__ unsigned pk2(float lo, float hi) { return f2bf(lo) | (f2bf(hi) << 16); }

#define XB_TMO      128
#define XB_XCNT(j)  (256  + 64 * (j))
#define XB_XSUB(j)  (1280 + 64 * (j))
#define XB_XGEN(j)  (2304 + 64 * (j))
#define XB_TOP      3328
#define XB_TOPGEN   3392
#define XCD_BAR_WORDS 3456
#define XB_SPIN_CAP (1u << 18)

__device__ __forceinline__ unsigned xb_ld(unsigned* p)              { return __hip_atomic_load(p, __ATOMIC_RELAXED, __HIP_MEMORY_SCOPE_AGENT); }
__device__ __forceinline__ unsigned xb_add(unsigned* p, unsigned v) { return __hip_atomic_fetch_add(p, v, __ATOMIC_RELAXED, __HIP_MEMORY_SCOPE_AGENT); }
__device__ __forceinline__ unsigned xb_xcc_id() { return (unsigned)__builtin_amdgcn_s_getreg((3 << 11) | 20) & 0xFu; }
#define XB_SPIN(cond, bar) do { unsigned _sp = 0; while (cond) { __builtin_amdgcn_s_sleep(1); \
    if ((++_sp & 255u) == 0u) { if (xb_ld(&(bar)[XB_TMO])) break; if (_sp > XB_SPIN_CAP) { atomicAdd(&(bar)[XB_TMO], 1u); break; } } } } while (0)

struct XcdBarrier {
    unsigned* bar; unsigned x;
    volatile LAS unsigned* st;
};

__device__ __forceinline__ XcdBarrier xcd_barrier_post(unsigned* bar, volatile LAS unsigned* st) {
    XcdBarrier b; b.bar = bar; b.x = xb_xcc_id(); b.st = st;
    if (threadIdx.x == 0) (void)xb_add(&bar[XB_XCNT(b.x)], 1u);
    return b;
}
__device__ __forceinline__ void xcd_barrier_complete(unsigned* bar, unsigned x, unsigned& nloc, unsigned& nx) {
    const unsigned G = gridDim.x * gridDim.y * gridDim.z;
    unsigned sum, cnt, mine, sp = 0u;
    for (;;) {
        sum = 0u; cnt = 0u; mine = 0u;
#pragma unroll
        for (unsigned j = 0; j < 16; ++j) { const unsigned c = xb_ld(&bar[XB_XCNT(j)]); sum += c; cnt += (c > 0u) ? 1u : 0u; mine = (j == x) ? c : mine; }
        if (sum == G) break;
        __builtin_amdgcn_s_sleep(1);
        if ((++sp & 255u) == 0u) { if (xb_ld(&bar[XB_TMO])) break; if (sp > XB_SPIN_CAP) { atomicAdd(&bar[XB_TMO], 1u); break; } }
    }
    nloc = mine > 0u ? mine : 1u; nx = cnt > 0u ? cnt : 1u;
}

__device__ __forceinline__ void xcd_barrier(const XcdBarrier& b) {
    asm volatile("s_waitcnt vmcnt(0)" ::: "memory");
    __syncthreads();
    if (threadIdx.x == 0) {
        unsigned* bar = b.bar;
        __builtin_amdgcn_s_waitcnt(0);
        unsigned nloc = b.st[0], nx = b.st[1];
        if (nloc == 0u) { xcd_barrier_complete(bar, b.x, nloc, nx); b.st[0] = nloc; b.st[1] = nx; }
        const unsigned old = xb_add(&bar[XB_XSUB(b.x)], 1u);
        const unsigned gen = old / nloc;
        if (old + 1u == (gen + 1u) * nloc) {
            __builtin_amdgcn_fence(__ATOMIC_RELEASE, "agent");
            asm volatile("s_waitcnt vmcnt(0)" ::: "memory");
            const unsigned og = xb_add(&bar[XB_TOP], 1u);
            const unsigned tg = og / nx;
            if (og + 1u == (tg + 1u) * nx) xb_add(&bar[XB_TOPGEN], 1u);
            else XB_SPIN(xb_ld(&bar[XB_TOPGEN]) == tg, bar);
            __builtin_amdgcn_fence(__ATOMIC_ACQUIRE, "agent");
            xb_add(&bar[XB_XGEN(b.x)], 1u);
            asm volatile("s_waitcnt vmcnt(0)" ::: "memory");
        } else {
            XB_SPIN(xb_ld(&bar[XB_XGEN(b.x)]) == gen, bar);
            __builtin_amdgcn_fence(__ATOMIC_ACQUIRE, "agent");
            asm volatile("s_waitcnt vmcnt(0)" ::: "memory");
        }
    }
    __syncthreads();
}
constexpr int NWAVES = 8;
constexpr int DM = 1024, BATCH = 8, SEQ = 4096, M = BATCH * SEQ, FF = 4096, INC = 2336, NP = 2560;
constexpr float EPS = 1e-6f;
constexpr int C_GQ = 0, C_GK = 256, C_GV = 512, C_GG = 1024, C_Z = 1536, C_SQ = 1568, C_SK = 2080, C_SV = 2208;
constexpr int P_GQ = 0, P_GK = 64, P_GV = 128, P_GG = 256, P_GH = 384, P_SQ = 1536, P_SK = 2048, P_SV = 2176, P_Z = 2304;
__host__ __device__ constexpr int src_col32(int jb) {
    return jb < 48 ? ((jb % 12) < 2 ? C_GQ + 64 * (jb / 12) + 32 * (jb % 12)
                    : (jb % 12) < 4 ? C_GK + 64 * (jb / 12) + 32 * ((jb % 12) - 2)
                    : (jb % 12) < 8 ? C_GV + 128 * (jb / 12) + 32 * ((jb % 12) - 4)
                                    : C_GG + 128 * (jb / 12) + 32 * ((jb % 12) - 8))
         : jb < 64 ? C_SQ + 32 * (jb - 48) : jb < 68 ? C_SK + 32 * (jb - 64) : jb < 72 ? C_SV + 32 * (jb - 68) : jb == 72 ? C_Z : -1;
}
constexpr size_t MiB = 1u << 20;
constexpr size_t WS_CTL = 0, CTL_ZERO_BYTES = 64 * 1024;
constexpr size_t WS_WIN = 2 * MiB, WS_WO = 8 * MiB, WS_WUP = 10 * MiB, WS_WDN = 18 * MiB;
constexpr size_t WS_U = 32 * MiB;
constexpr size_t WS_PROJ = 96 * MiB;
constexpr size_t WS_MIX = 256 * MiB;
constexpr size_t WS_H = 96 * MiB;
constexpr size_t WS_T = 352 * MiB;
constexpr size_t WS_END = 512 * MiB;
constexpr int CW_BAR = 1024;

constexpr int RING_OFF = 0, RING_BYTES = 131072;
constexpr int LDSCTL_OFF = RING_BYTES, MISC_OFF = LDSCTL_OFF + 320;
constexpr int LDS_BYTES = 147456;

__device__ __forceinline__ float bf2f(unsigned short v) { return __uint_as_float((unsigned)v << 16); }
__device__ __forceinline__ float wave_sum(float v) {
#pragma unroll
    for (int o = 1; o < 64; o <<= 1) v += __shfl_xor(v, o);
    return v;
}
__device__ __forceinline__ void transpose_item(const float* W, int ldw, int K, int src_n0, bf16* WT, int dst_row0, int k0, LAS float* scr, int lane) {
    if (src_n0 >= 0) {
#pragma unroll 8
        for (int i = 0; i < 32; ++i) { const int kk = 2 * i + (lane >> 5); scr[kk * 33 + (lane & 31)] = W[(size_t)(k0 + kk) * ldw + src_n0 + (lane & 31)]; }
    } else {
#pragma unroll 8
        for (int i = 0; i < 32; ++i) { const int kk = 2 * i + (lane >> 5); scr[kk * 33 + (lane & 31)] = 0.f; }
    }
    LDS_WAIT(); asm volatile("" ::: "memory");
    const int c = lane & 7;
#pragma unroll
    for (int j = 0; j < 4; ++j) { const int n = (lane >> 3) + 8 * j; const LAS float* s = scr + (8 * c) * 33 + n;
        v4u o; o.x = pk2(s[0 * 33], s[1 * 33]); o.y = pk2(s[2 * 33], s[3 * 33]); o.z = pk2(s[4 * 33], s[5 * 33]); o.w = pk2(s[6 * 33], s[7 * 33]);
        *(GAS v4u*)(WT + (size_t)(dst_row0 + n) * K + k0 + 8 * c) = o; }
    LDS_WAIT(); asm volatile("" ::: "memory");
}
__device__ __forceinline__ void rms_row_to_bf16(const float* xrow, const float* g, bf16* orow, int lane) {
    const GAS f32x4* xr = (const GAS f32x4*)xrow + lane;
    f32x4 v[4]; float s = 0.f;
#pragma unroll
    for (int j = 0; j < 4; ++j) { v[j] = xr[64 * j]; s += (v[j].x * v[j].x + v[j].y * v[j].y) + (v[j].z * v[j].z + v[j].w * v[j].w); }
    const float rs = 1.f / sqrtf(wave_sum(s) * (1.f / DM) + EPS);
    GAS unsigned long long* o8 = (GAS unsigned long long*)orow + lane;
#pragma unroll
    for (int j = 0; j < 4; ++j) { const f32x4 gg = ((const GAS f32x4*)g)[lane + 64 * j];
        o8[64 * j] = (unsigned long long)pk2(v[j].x * rs * gg.x, v[j].y * rs * gg.y) | ((unsigned long long)pk2(v[j].z * rs * gg.z, v[j].w * rs * gg.w) << 32); }
}
__device__ __forceinline__ float log_sigmoid(float x) { return fminf(x, 0.f) - log1pf(expf(-fabsf(x))); }
__device__ __forceinline__ int t5_bucket(int rel) {
    const int n = rel < 0 ? -rel : rel;
    const int large = 8 + (n >= 12) + (n >= 16) + (n >= 23) + (n >= 32) + (n >= 46) + (n >= 64) + (n >= 91);
    return (rel > 0 ? 16 : 0) + (n < 8 ? n : large);
}

namespace swa {
typedef float f32x16 __attribute__((ext_vector_type(16)));
typedef unsigned u32x2 __attribute__((ext_vector_type(2)));
using pg8::u32x4;
constexpr int KP = 144;
constexpr int VP = 776;
constexpr int OFF_K = 0, OFF_VT = 384 * KP, OFF_BIAS = OFF_VT + 64 * VP, BIAS_P = 260, LDS_NEED = OFF_BIAS + 4 * BIAS_P * 4;
constexpr float LOG2E = 1.4426950408889634f, C2 = 0.125f * LOG2E;
static_assert(LDS_NEED <= RING_BYTES, "swa LDS");
__device__ __forceinline__ int crow(int r, int hh) { return (r & 3) + 8 * (r >> 2) + 4 * hh; }

__device__ __forceinline__ void swa_unit(LAS unsigned char* L, int b, int kvh, int qblk, const bf16* PROJ, const float* sink, const float* relb, bf16* MIX, int tid, int lane, int wave) {
    const int kb0 = qblk - 1, hh = lane >> 5, l31 = lane & 31;
    const size_t rowbase = (size_t)b * SEQ;
#pragma unroll
    for (int it = 0; it < 6; ++it) {
        const int c = it * 512 + tid, kv = c >> 3, dch = c & 7, kabs = kb0 + (kv >> 7);
        if (kabs >= 0 && kabs < SEQ / 128) {
            const v4u val = *(const GAS v4u*)(PROJ + (rowbase + (size_t)(kb0 * 128 + kv)) * NP + P_SK + kvh * 64 + dch * 8);
            *(LAS v4u*)(L + OFF_K + kv * KP + dch * 16) = val;
        }
    }
#pragma unroll
    for (int it = 0; it < 6; ++it) {
        const int c = it * 512 + tid, dch = c / 384, kv = c % 384, kabs = kb0 + (kv >> 7);
        if (kabs >= 0 && kabs < SEQ / 128) {
            const v4u val = *(const GAS v4u*)(PROJ + (rowbase + (size_t)(kb0 * 128 + kv)) * NP + P_SV + kvh * 64 + dch * 8);
            LAS unsigned short* dst = (LAS unsigned short*)(L + OFF_VT + (dch * 8) * VP + kv * 2);
#pragma unroll
            for (int i = 0; i < 4; ++i) { const unsigned w = val[i]; dst[(2 * i) * (VP / 2)] = (unsigned short)(w & 0xffffu); dst[(2 * i + 1) * (VP / 2)] = (unsigned short)(w >> 16); }
        }
    }
    for (int i = tid; i < 4 * 257; i += NWAVES * 64) { const int g = i / 257, r = i % 257;
        ((LAS float*)(L + OFF_BIAS))[g * BIAS_P + r] = relb[t5_bucket(r - 128) * 8 + kvh * 4 + g] * LOG2E; }
    __syncthreads();
    const int g = wave >> 1, qh = kvh * 4 + g;
    const LAS float* biasT = (const LAS float*)(L + OFF_BIAS) + g * BIAS_P;
    const float sink2 = sink[qh] * LOG2E;
    for (int qq = 0; qq < 2; ++qq) {
        const int qb = (wave & 1) * 2 + qq, q_local = 32 * qb + l31;
        const size_t qrow = rowbase + (size_t)qblk * 128 + q_local;
        pg8::bf16x8 qf[4];
#pragma unroll
        for (int ks = 0; ks < 4; ++ks) qf[ks] = *(const GAS pg8::bf16x8*)(PROJ + qrow * NP + P_SQ + qh * 64 + 16 * ks + 8 * hh);
        float m = sink2, l = hh == 0 ? 1.f : 0.f;
        f32x16 o0, o1;
#pragma unroll
        for (int r = 0; r < 16; ++r) { o0[r] = 0.f; o1[r] = 0.f; }
        for (int kbl = 0; kbl < 3; ++kbl) {
            const int kabs = kb0 + kbl;
            if (kabs < 0 || kabs >= SEQ / 128) continue;
            f32x16 s[4];
#pragma unroll
            for (int t = 0; t < 4; ++t) {
#pragma unroll
                for (int r = 0; r < 16; ++r) s[t][r] = 0.f;
#pragma unroll
                for (int ks = 0; ks < 4; ++ks) {
                    const pg8::bf16x8 a = *(const LAS pg8::bf16x8*)(L + OFF_K + (kbl * 128 + t * 32 + l31) * KP + (16 * ks + 8 * hh) * 2);
                    s[t] = __builtin_amdgcn_mfma_f32_32x32x16_bf16(a, qf[ks], s[t], 0, 0, 0);
                }
            }
            const int relbase = (kbl - 1) * 128 - q_local;
            float mx = -1e30f;
#pragma unroll
            for (int t = 0; t < 4; ++t)
#pragma unroll
                for (int r = 0; r < 16; ++r) {
                    const int rel = relbase + t * 32 + crow(r, hh);
                    const bool valid = rel >= -128 && rel <= 128;
                    const int idx = min(max(rel + 128, 0), 256);
                    float v = fmaf(s[t][r], C2, biasT[idx]);
                    v = valid ? v : -1e30f; s[t][r] = v; mx = fmaxf(mx, v);
                }
            mx = fmaxf(mx, __shfl_xor(mx, 32));
            const float mn = fmaxf(m, mx), alpha = __builtin_amdgcn_exp2f(m - mn); m = mn;
            l *= alpha;
#pragma unroll
            for (int r = 0; r < 16; ++r) { o0[r] *= alpha; o1[r] *= alpha; }
#pragma unroll
            for (int t = 0; t < 4; ++t)
#pragma unroll
                for (int r = 0; r < 16; ++r) { const float p = __builtin_amdgcn_exp2f(s[t][r] - m); l += p; s[t][r] = p; }
#pragma unroll
            for (int t = 0; t < 4; ++t)
#pragma unroll
                for (int ss = 0; ss < 2; ++ss) {
                    u32x4 pw; pw.x = pg8::cvt_pk_bf16(s[t][8 * ss + 0], s[t][8 * ss + 1]); pw.y = pg8::cvt_pk_bf16(s[t][8 * ss + 2], s[t][8 * ss + 3]);
                    pw.z = pg8::cvt_pk_bf16(s[t][8 * ss + 4], s[t][8 * ss + 5]); pw.w = pg8::cvt_pk_bf16(s[t][8 * ss + 6], s[t][8 * ss + 7]);
                    const pg8::bf16x8 pb = __builtin_bit_cast(pg8::bf16x8, pw);
                    const int kvb = kbl * 128 + t * 32 + 16 * ss;
#pragma unroll
                    for (int dt = 0; dt < 2; ++dt) {
                        const LAS unsigned char* vp = L + OFF_VT + (dt * 32 + l31) * VP + (kvb + 4 * hh) * 2;
                        const u32x2 lo = *(const LAS u32x2*)vp, hi = *(const LAS u32x2*)(vp + 16);
                        u32x4 aw; aw.x = lo.x; aw.y = lo.y; aw.z = hi.x; aw.w = hi.y;
                        const pg8::bf16x8 va = __builtin_bit_cast(pg8::bf16x8, aw);
                        if (dt == 0) o0 = __builtin_amdgcn_mfma_f32_32x32x16_bf16(va, pb, o0, 0, 0, 0);
                        else         o1 = __builtin_amdgcn_mfma_f32_32x32x16_bf16(va, pb, o1, 0, 0, 0);
                    }
                }
        }
        l += __shfl_xor(l, 32);
        const float inv = 1.f / l;
        bf16* orow = MIX + qrow * DM + 512 + qh * 64;
#pragma unroll
        for (int dt = 0; dt < 2; ++dt)
#pragma unroll
            for (int rq = 0; rq < 4; ++rq) {
                const f32x16& o = dt == 0 ? o0 : o1;
                u32x2 w; w.x = pg8::cvt_pk_bf16(o[4 * rq] * inv, o[4 * rq + 1] * inv); w.y = pg8::cvt_pk_bf16(o[4 * rq + 2] * inv, o[4 * rq + 3] * inv);
                *(GAS u32x2*)(orow + dt * 32 + 8 * rq + 4 * hh) = w;
            }
    }
    __syncthreads();
}
}

namespace gla {
typedef float f32x16 __attribute__((ext_vector_type(16)));
using pg8::bf16x8; using pg8::u32x4; using pg8::cvt_pk_bf16;
constexpr int PT = 144;
constexpr int G1_KST = 0, G1_VT = 64 * PT, G1_DEC = G1_VT + 128 * PT, G1_HALF = G1_DEC + 256;
constexpr int G3_QF = 0, G3_QB = 64 * PT, G3_AM = 2 * 64 * PT, G3_VT = 3 * 64 * PT, G3_SF = G3_VT + 128 * PT, G3_SB = G3_SF + 128 * PT, G3_OST = G3_SB + 128 * PT,
              G3_KF = G3_OST, G3_KB = G3_OST + 64 * PT, OSTP = 528, G3_END = G3_OST + 64 * OSTP;
static_assert(2 * G1_HALF <= RING_BYTES && G3_END <= RING_BYTES && 2 * 64 * PT <= 64 * OSTP, "gla LDS");
__device__ __forceinline__ int crow(int r, int hh) { return (r & 3) + 8 * (r >> 2) + 4 * hh; }
__device__ __forceinline__ float fast_log_sigmoid(float x) { return fminf(x, 0.f) - __logf(1.f + __expf(-fabsf(x))); }
__device__ __forceinline__ void unpack8(const v4u v, float* f) {
#pragma unroll
    for (int i = 0; i < 4; ++i) { f[2 * i] = __uint_as_float(v[i] << 16); f[2 * i + 1] = __uint_as_float(v[i] & 0xffff0000u); }
}
template <int NCH, bool SUFFIX>
__device__ __forceinline__ void gate_cumsum(const float (&z)[16], const float* wg_, const float* bg_, int hc0, float (&bs)[NCH], float (&tot)[NCH], int lane) {
    typedef const __attribute__((address_space(4))) float* cfp;
    const cfp wg = (cfp)wg_; const cfp bg = (cfp)bg_;
#pragma unroll
    for (int c = 0; c < NCH; ++c) {
        float pre = bg[hc0 + c];
#pragma unroll
        for (int r = 0; r < 16; ++r) pre = fmaf(z[r], wg[r * 256 + hc0 + c], pre);
        float v = fast_log_sigmoid(pre) * (1.f / 16.f);
        if (!SUFFIX) {
#pragma unroll
            for (int o = 1; o < 64; o <<= 1) { const float t = __shfl_up(v, o); v += (lane >= o) ? t : 0.f; }
            tot[c] = __shfl(v, 63);
        } else {
#pragma unroll
            for (int o = 1; o < 64; o <<= 1) { const float t = __shfl_down(v, o); v += (lane + o < 64) ? t : 0.f; }
            tot[c] = __shfl(v, 0);
        }
        bs[c] = v;
    }
}

__device__ __forceinline__ void g1_unit(LAS unsigned char* L, int bh, int run, const bf16* PROJ, const float* wgf, const float* bgf, const float* wgb, const float* bgb,
                                        bf16* LST, float* TRUN, float* CUMP, float* LOGD, int lane, int wave) {
    const int dir = wave >> 2, wq = wave & 3, hh = lane >> 5, l31 = lane & 31, b = bh >> 2, h = bh & 3;
    const float* wg = dir ? wgb : wgf; const float* bg = dir ? bgb : bgf;
    LAS unsigned char* Lh = L + dir * G1_HALF;
    f32x16 acc[2];
#pragma unroll
    for (int r = 0; r < 16; ++r) { acc[0][r] = 0.f; acc[1][r] = 0.f; }
    float cum[16];
#pragma unroll
    for (int c = 0; c < 16; ++c) cum[c] = 0.f;
    for (int j = 0; j < 8; ++j) {
        const int cn = dir ? (8 * run + 7 - j) : (8 * run + j), cg = bh * 64 + cn;
        const bf16* prow = PROJ + ((size_t)b * SEQ + 64 * cn + lane) * NP;
        float z[16], k[16], bs[16], tot[16];
        { const v4u z0 = *(const GAS v4u*)(prow + P_Z + dir * 16), z1 = *(const GAS v4u*)(prow + P_Z + dir * 16 + 8); unpack8(z0, z); unpack8(z1, z + 8); }
        { const v4u k0 = *(const GAS v4u*)(prow + P_GH * h + P_GK + 16 * wq), k1 = *(const GAS v4u*)(prow + P_GH * h + P_GK + 16 * wq + 8); unpack8(k0, k); unpack8(k1, k + 8); }
        v4u vv[4];
#pragma unroll
        for (int i = 0; i < 4; ++i) vv[i] = *(const GAS v4u*)(prow + P_GH * h + P_GV + 32 * wq + 8 * i);
        if (dir) gate_cumsum<16, true>(z, wg, bg, h * 64 + 16 * wq, bs, tot, lane); else gate_cumsum<16, false>(z, wg, bg, h * 64 + 16 * wq, bs, tot, lane);
#pragma unroll
        for (int c = 0; c < 16; ++c) {
            const float kst = k[c] * __expf(tot[c] - bs[c]);
            *(LAS unsigned short*)(Lh + G1_KST + (16 * wq + c) * PT + lane * 2) = (unsigned short)f2bf(kst);
            if (lane == 0) { ((LAS float*)(Lh + G1_DEC))[16 * wq + c] = __expf(tot[c]); CUMP[((size_t)cg * 2 + dir) * 64 + 16 * wq + c] = cum[c]; }
            cum[c] += tot[c];
        }
#pragma unroll
        for (int i = 0; i < 4; ++i)
#pragma unroll
            for (int q = 0; q < 4; ++q) { const unsigned w = vv[i][q];
                *(LAS unsigned short*)(Lh + G1_VT + (32 * wq + 8 * i + 2 * q) * PT + lane * 2) = (unsigned short)(w & 0xffffu);
                *(LAS unsigned short*)(Lh + G1_VT + (32 * wq + 8 * i + 2 * q + 1) * PT + lane * 2) = (unsigned short)(w >> 16); }
        __syncthreads();
        bf16* lst = LST + ((size_t)cg * 2 + dir) * 8192;
#pragma unroll
        for (int dt = 0; dt < 2; ++dt) {
            const float dec = ((const LAS float*)(Lh + G1_DEC))[dt * 32 + l31];
#pragma unroll
            for (int r = 0; r < 16; ++r) { lst[(32 * wq + crow(r, hh)) * 64 + dt * 32 + l31] = (bf16)f2bf(acc[dt][r]); acc[dt][r] *= dec; }
        }
#pragma unroll
        for (int ks = 0; ks < 4; ++ks) {
            const bf16x8 a = *(const LAS bf16x8*)(Lh + G1_VT + (32 * wq + l31) * PT + (16 * ks + 8 * hh) * 2);
#pragma unroll
            for (int dt = 0; dt < 2; ++dt) {
                const bf16x8 bq = *(const LAS bf16x8*)(Lh + G1_KST + (dt * 32 + l31) * PT + (16 * ks + 8 * hh) * 2);
                acc[dt] = __builtin_amdgcn_mfma_f32_32x32x16_bf16(a, bq, acc[dt], 0, 0, 0);
            }
        }
        __syncthreads();
    }
    float* tr = TRUN + ((size_t)(bh * 8 + run) * 2 + dir) * 8192;
#pragma unroll
    for (int dt = 0; dt < 2; ++dt)
#pragma unroll
        for (int r = 0; r < 16; ++r) tr[(32 * wq + crow(r, hh)) * 64 + dt * 32 + l31] = acc[dt][r];
    if (lane == 0) {
#pragma unroll
        for (int c = 0; c < 16; ++c) LOGD[((size_t)(bh * 8 + run) * 2 + dir) * 64 + 16 * wq + c] = cum[c];
    }
}

__device__ __forceinline__ void g3_unit(LAS unsigned char* L, int bh, int run, const bf16* PROJ, const float* wgf, const float* bgf, const float* wgb, const float* bgb, const float* gn,
                                        const bf16* LST, const float* TRUN, const float* CUMP, const float* LOGD, bf16* MIX, int tid, int lane, int wave) {
    const int hh = lane >> 5, l31 = lane & 31, b = bh >> 2, h = bh & 3;
    const int ce = tid >> 2, cd0 = (tid & 3) * 16;
    float Cf[16], Cb[16];
#pragma unroll
    for (int i = 0; i < 16; ++i) { Cf[i] = 0.f; Cb[i] = 0.f; }
    for (int m = 0; m < run; ++m) {
        const float* ld = LOGD + ((size_t)(bh * 8 + m) * 2 + 0) * 64 + cd0; const float* tr = TRUN + ((size_t)(bh * 8 + m) * 2 + 0) * 8192 + ce * 64 + cd0;
#pragma unroll
        for (int q = 0; q < 4; ++q) { const f32x4 lv = *(const GAS f32x4*)(ld + 4 * q), tv = *(const GAS f32x4*)(tr + 4 * q);
#pragma unroll
            for (int i = 0; i < 4; ++i) Cf[4 * q + i] = fmaf(__expf(lv[i]), Cf[4 * q + i], tv[i]); }
    }
    for (int m = 7; m > run; --m) {
        const float* ld = LOGD + ((size_t)(bh * 8 + m) * 2 + 1) * 64 + cd0; const float* tr = TRUN + ((size_t)(bh * 8 + m) * 2 + 1) * 8192 + ce * 64 + cd0;
#pragma unroll
        for (int q = 0; q < 4; ++q) { const f32x4 lv = *(const GAS f32x4*)(ld + 4 * q), tv = *(const GAS f32x4*)(tr + 4 * q);
#pragma unroll
            for (int i = 0; i < 4; ++i) Cb[4 * q + i] = fmaf(__expf(lv[i]), Cb[4 * q + i], tv[i]); }
    }
    for (int j = 0; j < 8; ++j) {
        const int cn = 8 * run + j, cg = bh * 64 + cn;
        const size_t tok0 = (size_t)b * SEQ + 64 * cn;
        const bf16* prow = PROJ + (tok0 + lane) * NP;
        {
            float zf[16], zb[16], q8[8], k8[8], bf[8], bb[8], totf[8], totb[8];
            { const v4u z0 = *(const GAS v4u*)(prow + P_Z), z1 = *(const GAS v4u*)(prow + P_Z + 8), z2 = *(const GAS v4u*)(prow + P_Z + 16), z3 = *(const GAS v4u*)(prow + P_Z + 24);
              unpack8(z0, zf); unpack8(z1, zf + 8); unpack8(z2, zb); unpack8(z3, zb + 8); }
            { const v4u qv = *(const GAS v4u*)(prow + P_GH * h + P_GQ + 8 * wave), kv = *(const GAS v4u*)(prow + P_GH * h + P_GK + 8 * wave); unpack8(qv, q8); unpack8(kv, k8); }
            const v4u v0 = *(const GAS v4u*)(prow + P_GH * h + P_GV + 16 * wave), v1 = *(const GAS v4u*)(prow + P_GH * h + P_GV + 16 * wave + 8);
            gate_cumsum<8, false>(zf, wgf, bgf, h * 64 + 8 * wave, bf, totf, lane);
            gate_cumsum<8, true>(zb, wgb, bgb, h * 64 + 8 * wave, bb, totb, lane);
            float qf[8], kf[8], qb[8], kb[8];
#pragma unroll
            for (int c = 0; c < 8; ++c) { const float qs = q8[c] * 0.125f;
                qf[c] = qs * __expf(bf[c]); kf[c] = k8[c] * __expf(-bf[c]); qb[c] = qs * __expf(bb[c]); kb[c] = k8[c] * __expf(-bb[c]); }
#define GLA_PK8(x) (v4u){cvt_pk_bf16(x[0], x[1]), cvt_pk_bf16(x[2], x[3]), cvt_pk_bf16(x[4], x[5]), cvt_pk_bf16(x[6], x[7])}
            *(LAS v4u*)(L + G3_QF + lane * PT + wave * 16) = GLA_PK8(qf);
            *(LAS v4u*)(L + G3_KF + lane * PT + wave * 16) = GLA_PK8(kf);
            *(LAS v4u*)(L + G3_QB + lane * PT + wave * 16) = GLA_PK8(qb);
            *(LAS v4u*)(L + G3_KB + lane * PT + wave * 16) = GLA_PK8(kb);
#pragma unroll
            for (int q = 0; q < 4; ++q) {
                *(LAS unsigned short*)(L + G3_VT + (16 * wave + 2 * q) * PT + lane * 2) = (unsigned short)(v0[q] & 0xffffu);
                *(LAS unsigned short*)(L + G3_VT + (16 * wave + 2 * q + 1) * PT + lane * 2) = (unsigned short)(v0[q] >> 16);
                *(LAS unsigned short*)(L + G3_VT + (16 * wave + 8 + 2 * q) * PT + lane * 2) = (unsigned short)(v1[q] & 0xffffu);
                *(LAS unsigned short*)(L + G3_VT + (16 * wave + 8 + 2 * q + 1) * PT + lane * 2) = (unsigned short)(v1[q] >> 16); }
        }
#pragma unroll
        for (int dir = 0; dir < 2; ++dir) {
            const float* cp = CUMP + ((size_t)cg * 2 + dir) * 64 + cd0; const bf16* ls = LST + ((size_t)cg * 2 + dir) * 8192 + ce * 64 + cd0;
            float lf[16], s[16];
            { const v4u a0 = *(const GAS v4u*)ls, a1 = *(const GAS v4u*)(ls + 8); unpack8(a0, lf); unpack8(a1, lf + 8); }
#pragma unroll
            for (int q = 0; q < 4; ++q) { const f32x4 pv = *(const GAS f32x4*)(cp + 4 * q);
#pragma unroll
                for (int i = 0; i < 4; ++i) s[4 * q + i] = fmaf(__expf(pv[i]), dir ? Cb[4 * q + i] : Cf[4 * q + i], lf[4 * q + i]); }
            LAS unsigned char* dst = L + (dir ? G3_SB : G3_SF) + ce * PT + cd0 * 2;
            *(LAS v4u*)dst = GLA_PK8(s); *(LAS v4u*)(dst + 16) = GLA_PK8((s + 8));
        }
        __syncthreads();
        if (wave < 4) {
            const int ct = (wave == 1 || wave == 2) ? 1 : 0, st = (wave == 1 || wave == 3) ? 1 : 0;
            f32x16 af, ab;
#pragma unroll
            for (int r = 0; r < 16; ++r) { af[r] = 0.f; ab[r] = 0.f; }
            if (wave != 3) {
#pragma unroll
                for (int ks = 0; ks < 4; ++ks) { const bf16x8 a = *(const LAS bf16x8*)(L + G3_QF + (ct * 32 + l31) * PT + (16 * ks + 8 * hh) * 2), bq = *(const LAS bf16x8*)(L + G3_KF + (st * 32 + l31) * PT + (16 * ks + 8 * hh) * 2);
                    af = __builtin_amdgcn_mfma_f32_32x32x16_bf16(a, bq, af, 0, 0, 0); }
            }
            if (wave != 2) {
#pragma unroll
                for (int ks = 0; ks < 4; ++ks) { const bf16x8 a = *(const LAS bf16x8*)(L + G3_QB + (ct * 32 + l31) * PT + (16 * ks + 8 * hh) * 2), bq = *(const LAS bf16x8*)(L + G3_KB + (st * 32 + l31) * PT + (16 * ks + 8 * hh) * 2);
                    ab = __builtin_amdgcn_mfma_f32_32x32x16_bf16(a, bq, ab, 0, 0, 0); }
            }
            const int scol = st * 32 + l31;
#pragma unroll
            for (int r = 0; r < 16; ++r) { const int c = ct * 32 + crow(r, hh);
                const float v = ((scol <= c) ? af[r] : 0.f) + ((scol >= c) ? ab[r] : 0.f);
                *(LAS unsigned short*)(L + G3_AM + c * PT + scol * 2) = (unsigned short)f2bf(v); }
        }
        __syncthreads();
        {
            const int ct = wave >> 2, et = wave & 3;
            f32x16 o;
#pragma unroll
            for (int r = 0; r < 16; ++r) o[r] = 0.f;
#pragma unroll
            for (int ks = 0; ks < 4; ++ks) { const bf16x8 a = *(const LAS bf16x8*)(L + G3_AM + (ct * 32 + l31) * PT + (16 * ks + 8 * hh) * 2), bq = *(const LAS bf16x8*)(L + G3_VT + (et * 32 + l31) * PT + (16 * ks + 8 * hh) * 2);
                o = __builtin_amdgcn_mfma_f32_32x32x16_bf16(a, bq, o, 0, 0, 0); }
#pragma unroll
            for (int ks = 0; ks < 4; ++ks) { const bf16x8 a = *(const LAS bf16x8*)(L + G3_QF + (ct * 32 + l31) * PT + (16 * ks + 8 * hh) * 2), bq = *(const LAS bf16x8*)(L + G3_SF + (et * 32 + l31) * PT + (16 * ks + 8 * hh) * 2);
                o = __builtin_amdgcn_mfma_f32_32x32x16_bf16(a, bq, o, 0, 0, 0); }
#pragma unroll
            for (int ks = 0; ks < 4; ++ks) { const bf16x8 a = *(const LAS bf16x8*)(L + G3_QB + (ct * 32 + l31) * PT + (16 * ks + 8 * hh) * 2), bq = *(const LAS bf16x8*)(L + G3_SB + (et * 32 + l31) * PT + (16 * ks + 8 * hh) * 2);
                o = __builtin_amdgcn_mfma_f32_32x32x16_bf16(a, bq, o, 0, 0, 0); }
#pragma unroll
            for (int r = 0; r < 16; ++r) *(LAS float*)(L + G3_OST + (ct * 32 + crow(r, hh)) * OSTP + (et * 32 + l31) * 4) = o[r];
        }
        __syncthreads();
        {
            const int tok = tid >> 3, eq = tid & 7;
            float ov[16]; float ss = 0.f;
#pragma unroll
            for (int q = 0; q < 4; ++q) { const f32x4 t = *(const LAS f32x4*)(L + G3_OST + tok * OSTP + eq * 64 + q * 16);
#pragma unroll
                for (int i = 0; i < 4; ++i) { ov[4 * q + i] = t[i]; ss = fmaf(t[i], t[i], ss); } }
            ss += __shfl_xor(ss, 1); ss += __shfl_xor(ss, 2); ss += __shfl_xor(ss, 4);
            const float rs = 1.f / sqrtf(ss * (1.f / 128.f) + EPS);
            const bf16* grow = PROJ + (tok0 + tok) * NP + P_GH * h + P_GG + 16 * eq;
            float gt[16];
            { const v4u g0 = *(const GAS v4u*)grow, g1 = *(const GAS v4u*)(grow + 8); unpack8(g0, gt); unpack8(g1, gt + 8); }
            float res[16];
#pragma unroll
            for (int q = 0; q < 4; ++q) { const f32x4 nv = *(const GAS f32x4*)(gn + 16 * eq + 4 * q);
#pragma unroll
                for (int i = 0; i < 4; ++i) { const float gv = gt[4 * q + i]; res[4 * q + i] = ov[4 * q + i] * rs * nv[i] * (gv / (1.f + __expf(-gv))); } }
            bf16* orow = MIX + (tok0 + tok) * DM + h * 128 + 16 * eq;
            *(GAS v4u*)orow = GLA_PK8(res); *(GAS v4u*)(orow + 8) = GLA_PK8((res + 8));
        }
        __syncthreads();
    }
#undef GLA_PK8
}
}

__device__ __forceinline__ void norm_mid_row(const float* trow, const float* xrow, const float* g1, const float* g2, float* orow, bf16* xnrow, int lane) {
    f32x4 t[4], h[4]; float s = 0.f;
#pragma unroll
    for (int j = 0; j < 4; ++j) { t[j] = ((const GAS f32x4*)trow)[lane + 64 * j]; s += (t[j].x * t[j].x + t[j].y * t[j].y) + (t[j].z * t[j].z + t[j].w * t[j].w); }
    const float rs = 1.f / sqrtf(wave_sum(s) * (1.f / DM) + EPS); float s2 = 0.f;
#pragma unroll
    for (int j = 0; j < 4; ++j) { const f32x4 gg = ((const GAS f32x4*)g1)[lane + 64 * j], xx = ((const GAS f32x4*)xrow)[lane + 64 * j];
        h[j] = xx + t[j] * rs * gg; ((GAS f32x4*)orow)[lane + 64 * j] = h[j]; s2 += (h[j].x * h[j].x + h[j].y * h[j].y) + (h[j].z * h[j].z + h[j].w * h[j].w); }
    const float rs2 = 1.f / sqrtf(wave_sum(s2) * (1.f / DM) + EPS);
    GAS unsigned long long* o8 = (GAS unsigned long long*)xnrow + lane;
#pragma unroll
    for (int j = 0; j < 4; ++j) { const f32x4 gg = ((const GAS f32x4*)g2)[lane + 64 * j];
        o8[64 * j] = (unsigned long long)pk2(h[j].x * rs2 * gg.x, h[j].y * rs2 * gg.y) | ((unsigned long long)pk2(h[j].z * rs2 * gg.z, h[j].w * rs2 * gg.w) << 32); }
}
__device__ __forceinline__ void norm_final_row(const float* trow, const float* g, float* orow, int lane) {
    f32x4 t[4]; float s = 0.f;
#pragma unroll
    for (int j = 0; j < 4; ++j) { t[j] = ((const GAS f32x4*)trow)[lane + 64 * j]; s += (t[j].x * t[j].x + t[j].y * t[j].y) + (t[j].z * t[j].z + t[j].w * t[j].w); }
    const float rs = 1.f / sqrtf(wave_sum(s) * (1.f / DM) + EPS);
#pragma unroll
    for (int j = 0; j < 4; ++j) { const f32x4 gg = ((const GAS f32x4*)g)[lane + 64 * j]; GAS f32x4* op = (GAS f32x4*)orow + lane + 64 * j; *op = *op + t[j] * rs * gg; }
}

struct Args { const float* in[16]; float* out; unsigned char* ws; };
__global__ void __launch_bounds__(NWAVES * 64, 2) fwd_megakernel(Args args) {
    extern __shared__ __attribute__((aligned(16))) unsigned char lds[];
    LAS unsigned char* L = (LAS unsigned char*)lds;
    volatile LAS unsigned* MISC = (volatile LAS unsigned*)(L + MISC_OFF);
    const int tid = threadIdx.x, lane = tid & 63, wave = __builtin_amdgcn_readfirstlane(tid >> 6);
    const int G = gridDim.x; const int bx = blockIdx.x; const int vcu = (G % 8 == 0) ? (bx % 8) * (G / 8) + bx / 8 : bx;
    const int gw = vcu * NWAVES + wave, NGW = G * NWAVES;
    unsigned char* ws = args.ws;
    gu32* ctl = (gu32*)(ws + WS_CTL);
    const float* x = args.in[0]; const float* g_pre = args.in[1]; const float* w_in = args.in[2];
    const float* wgf = args.in[3]; const float* bgf = args.in[4]; const float* wgb = args.in[5]; const float* bgb = args.in[6];
    const float* gla_norm = args.in[7]; const float* sink = args.in[8]; const float* relb = args.in[9];
    const float* w_out = args.in[10]; const float* g_post = args.in[11]; const float* g_mlp_pre = args.in[12];
    const float* w_up = args.in[13]; const float* w_down = args.in[14]; const float* g_mlp_post = args.in[15];
    float* out = args.out;
    bf16* Win_t = (bf16*)(ws + WS_WIN); bf16* Wo_t = (bf16*)(ws + WS_WO); bf16* Wup_t = (bf16*)(ws + WS_WUP); bf16* Wdn_t = (bf16*)(ws + WS_WDN);
    bf16* U = (bf16*)(ws + WS_U); bf16* PROJ = (bf16*)(ws + WS_PROJ); bf16* MIX = (bf16*)(ws + WS_MIX); bf16* HB = (bf16*)(ws + WS_H);
    float* T = (float*)(ws + WS_T);
    bf16* LST = (bf16*)(ws + WS_T); float* TRUN = (float*)(ws + WS_T + 64 * MiB); float* CUMP = (float*)(ws + WS_T + 80 * MiB); float* LOGD = (float*)(ws + WS_T + 81 * MiB);

    for (int u = tid; u < (LDS_BYTES - LDSCTL_OFF) / 4; u += NWAVES * 64) ((LAS unsigned*)(L + LDSCTL_OFF))[u] = 0u;
    __syncthreads();
    XcdBarrier bar = xcd_barrier_post((unsigned*)(ctl + CW_BAR), MISC + 8);

    {
        LAS float* scr = (LAS float*)(L + RING_OFF + wave * 16384);
        constexpr int I_IN = 16 * (NP / 32), I_O = 16 * 32, I_UP = 16 * 128, I_DN = 64 * 32, NITEMS = I_IN + I_O + I_UP + I_DN;
        for (int it = gw; it < NITEMS; it += NGW) {
            int r = it;
            if (r < I_IN) { const int kb = r / (NP / 32), jb = r % (NP / 32); transpose_item(w_in, INC, DM, src_col32(jb), Win_t, 32 * jb, 64 * kb, scr, lane); continue; } r -= I_IN;
            if (r < I_O) { const int kb = r / 32, jb = r % 32; transpose_item(w_out, DM, DM, 32 * jb, Wo_t, 32 * jb, 64 * kb, scr, lane); continue; } r -= I_O;
            if (r < I_UP) { const int kb = r / 128, jb = r % 128; transpose_item(w_up, FF, DM, 32 * jb, Wup_t, 32 * jb, 64 * kb, scr, lane); continue; } r -= I_UP;
            { const int kb = r / 32, jb = r % 32; transpose_item(w_down, DM, FF, 32 * jb, Wdn_t, 32 * jb, 64 * kb, scr, lane); }
        }
        for (int m = gw; m < M; m += NGW) rms_row_to_bf16(x + (size_t)m * DM, g_pre, U + (size_t)m * DM, lane);
    }
    xcd_barrier(bar);

    {
        pg8::Gemm g{U, Win_t, M, NP, DM}; pg8::StaticOrder S; S.init(M, NP, G, bx);
        pg8::EpiBf16<0> E{PROJ, NP};
        pg8::gemm_phase<pg8::EpiBf16<0>, pg8::StaticOrder, true, true>(L + RING_OFF, g, S, E);
    }
    xcd_barrier(bar);

    for (int id = vcu; id < BATCH * 4 * 8; id += G) gla::g1_unit(L + RING_OFF, id >> 3, id & 7, PROJ, wgf, bgf, wgb, bgb, LST, TRUN, CUMP, LOGD, lane, wave);
    for (int id = vcu; id < BATCH * 2 * (SEQ / 128); id += G) swa::swa_unit(L + RING_OFF, id >> 6, (id >> 5) & 1, id & 31, PROJ, sink, relb, MIX, tid, lane, wave);
    xcd_barrier(bar);
    for (int id = vcu; id < BATCH * 4 * 8; id += G) gla::g3_unit(L + RING_OFF, id >> 3, id & 7, PROJ, wgf, bgf, wgb, bgb, gla_norm, LST, TRUN, CUMP, LOGD, MIX, tid, lane, wave);
    xcd_barrier(bar);

    {
        pg8::Gemm g{MIX, Wo_t, M, DM, DM}; pg8::StaticOrder S; S.init(M, DM, G, bx);
        pg8::EpiF32 E{T, DM};
        pg8::gemm_phase<pg8::EpiF32, pg8::StaticOrder, true, true>(L + RING_OFF, g, S, E);
    }
    xcd_barrier(bar);
    for (int m = gw; m < M; m += NGW) norm_mid_row(T + (size_t)m * DM, x + (size_t)m * DM, g_post, g_mlp_pre, out + (size_t)m * DM, U + (size_t)m * DM, lane);
    xcd_barrier(bar);

    {
        pg8::Gemm g{U, Wup_t, M, FF, DM}; pg8::StaticOrder S; S.init(M, FF, G, bx);
        pg8::EpiBf16<1> E{HB, FF};
        pg8::gemm_phase<pg8::EpiBf16<1>, pg8::StaticOrder, true, true>(L + RING_OFF, g, S, E);
    }
    xcd_barrier(bar);

    {
        pg8::Gemm g{HB, Wdn_t, M, DM, FF}; pg8::StaticOrder S; S.init(M, DM, G, bx);
        pg8::EpiF32 E{T, DM};
        pg8::gemm_phase<pg8::EpiF32, pg8::StaticOrder, true, true>(L + RING_OFF, g, S, E);
    }
    xcd_barrier(bar);
    for (int m = gw; m < M; m += NGW) norm_final_row(T + (size_t)m * DM, g_mlp_post, out + (size_t)m * DM, lane);
}

extern "C" void kernel_launch(void* const* d_in, const int* in_sizes, int n_in, void* d_out, int out_size, void* d_ws, size_t ws_size, hipStream_t stream) {
    static int grid = 0;
    if (grid == 0) {
        if (n_in != 16 || in_sizes[0] != M * DM || out_size != M * DM || ws_size < WS_END) { fprintf(stderr, "kernel_launch: unexpected shapes / workspace (n_in %d, in0 %d, out %d, ws %zu); nothing launched\n", n_in, n_in > 0 ? in_sizes[0] : -1, out_size, ws_size); grid = -1; return; }
        int dev = 0, cus = 0, per_cu = 0;
        if (hipGetDevice(&dev) != hipSuccess || hipDeviceGetAttribute(&cus, hipDeviceAttributeMultiprocessorCount, dev) != hipSuccess) { fprintf(stderr, "kernel_launch: device query failed\n"); grid = -1; return; }
        if (hipFuncSetAttribute((const void*)fwd_megakernel, hipFuncAttributeMaxDynamicSharedMemorySize, LDS_BYTES) != hipSuccess) { fprintf(stderr, "kernel_launch: hipFuncSetAttribute failed\n"); grid = -1; return; }
        if (hipOccupancyMaxActiveBlocksPerMultiprocessor(&per_cu, (const void*)fwd_megakernel, NWAVES * 64, LDS_BYTES) != hipSuccess || per_cu < 1) { fprintf(stderr, "kernel_launch: occupancy query reports %d workgroups per CU\n", per_cu); per_cu = per_cu < 1 ? 1 : per_cu; }
        (void)hipGetLastError();
        grid = cus;
    }
    if (grid < 0) return;
    if (hipMemsetAsync((char*)d_ws + WS_CTL, 0, CTL_ZERO_BYTES, stream) != hipSuccess) { fprintf(stderr, "kernel_launch: memset failed\n"); return; }
    Args a{};
    for (int i = 0; i < 16; ++i) a.in[i] = (const float*)d_in[i];
    a.out = (float*)d_out; a.ws = (unsigned char*)d_ws;
    hipLaunchKernelGGL(fwd_megakernel, dim3(grid), dim3(NWAVES * 64), LDS_BYTES, stream, a);
    const hipError_t le = hipPeekAtLastError();
    if (le != hipSuccess) fprintf(stderr, "kernel_launch: launch failed: %s\n", hipGetErrorName(le));
}
```
